# Optimizing an MI355X kernel written in HIP

```python
import jax
import jax.numpy as jnp
from jax import lax
import numpy as np

D_MODEL = 2048
BATCH = 2
SEQ = 4096
DEPTH = 1

CTX_LEN = 256
GRID_W = 64
N_HEADS = 8
DH_QK = D_MODEL // 16
DH_V = D_MODEL // 8
D_QK = N_HEADS * DH_QK
D_V = N_HEADS * DH_V
D_CONV = D_MODEL // 2
CONV_W = 31
CONV_PAD = CONV_W // 2
D_FF = 256 * ((8 * D_MODEL // 3 + 255) // 256)
CHUNK = 128
N_GATE = 4 * N_HEADS
OFF_K = 0
OFF_V = OFF_K + D_QK
OFF_GATE = OFF_V + D_V
N_STATE_COLS = OFF_GATE + N_GATE
OFF_Q = N_STATE_COLS
OFF_O = OFF_Q + D_QK
OFF_GLU = OFF_O + D_V
OFF_MERGE = OFF_GLU + 2 * D_CONV
N_IN = OFF_MERGE + 2 * D_MODEL
DEEPNORM_ALPHA = (2.0 * DEPTH) ** 0.25
DEEPNORM_BETA = (8.0 * DEPTH) ** -0.25
FFN_RES_WEIGHT = 0.5
LN_EPS = 1e-5
M_INIT = -1e4

kernel_name = 'bidir_mlstm_conformer_macaron_hybrid'


def layer_norm(x, g, b=None):
    xf = x.astype(jnp.float32)
    mu = jnp.mean(xf, axis=-1, keepdims=True)
    var = jnp.mean(jnp.square(xf - mu), axis=-1, keepdims=True)
    y = (xf - mu) * lax.rsqrt(var + LN_EPS) * g
    if b is not None:
        y = y + b
    return y.astype(x.dtype)


def swiglu(h, w13, w2):
    a, g = jnp.split(h @ w13, 2, axis=-1)
    return (jax.nn.silu(a) * g) @ w2


def to_heads(p, dh):
    bsz, t, _ = p.shape
    return p.reshape(bsz, t, N_HEADS, dh).transpose(0, 2, 1, 3)


def flip_t(a):
    return jnp.flip(a, axis=2)


def zero_state(bsz):
    return (jnp.zeros((bsz, N_HEADS, DH_QK, DH_V), jnp.float32),
            jnp.zeros((bsz, N_HEADS, DH_QK), jnp.float32),
            jnp.full((bsz, N_HEADS), M_INIT, jnp.float32))


def mlstm_states(k, v, li, lf, state0):
    bsz, nh, t, dk = k.shape
    nc = t // CHUNK
    kc = k.reshape(bsz, nh, nc, CHUNK, dk)
    vc = v.reshape(bsz, nh, nc, CHUNK, v.shape[-1])
    lic = li.reshape(bsz, nh, nc, CHUNK)
    b = jnp.cumsum(lf.reshape(bsz, nh, nc, CHUNK), axis=-1)
    g = b[..., -1]
    a = g[..., None] - b + lic
    m_loc = jnp.max(a, axis=-1)
    kw = kc * jnp.exp(a - m_loc[..., None])[..., None]
    c_in = jnp.einsum('bhcld,bhcle->bhcde', kw, vc)
    n_in = jnp.sum(kw, axis=-2)

    def step(carry, inp):
        cm, nv, m = carry
        c_i, n_i, g_i, ml_i = inp
        m_new = jnp.maximum(g_i + m, ml_i)
        s_old = jnp.exp(g_i + m - m_new)
        s_in = jnp.exp(ml_i - m_new)
        c_new = s_old[..., None, None] * cm + s_in[..., None, None] * c_i
        n_new = s_old[..., None] * nv + s_in[..., None] * n_i
        return (c_new, n_new, m_new), (cm, nv, m)

    xs = (jnp.moveaxis(c_in, 2, 0), jnp.moveaxis(n_in, 2, 0),
          jnp.moveaxis(g, 2, 0), jnp.moveaxis(m_loc, 2, 0))
    final, starts = lax.scan(step, state0, xs)
    starts = (jnp.moveaxis(starts[0], 0, 2), jnp.moveaxis(starts[1], 0, 2), jnp.moveaxis(starts[2], 0, 2))
    return starts, final


def mlstm_outputs(q, k, v, li, lf, starts):
    c0, n0, m0 = starts
    bsz, nh, t, dk = q.shape
    nc = t // CHUNK
    qc = q.reshape(bsz, nh, nc, CHUNK, dk)
    kc = k.reshape(bsz, nh, nc, CHUNK, dk)
    vc = v.reshape(bsz, nh, nc, CHUNK, v.shape[-1])
    lic = li.reshape(bsz, nh, nc, CHUNK)
    b = jnp.cumsum(lf.reshape(bsz, nh, nc, CHUNK), axis=-1)
    lower = jnp.tril(jnp.ones((CHUNK, CHUNK), dtype=bool))
    d = jnp.where(lower, b[..., :, None] - b[..., None, :] + lic[..., None, :], -jnp.inf)
    m_inter = b + m0[..., None]
    m_j = jnp.maximum(m_inter, jnp.max(d, axis=-1))
    w_intra = jnp.exp(d - m_j[..., None])
    w_inter = jnp.exp(m_inter - m_j)
    s = jnp.einsum('bhcjd,bhcsd->bhcjs', qc, kc) * w_intra
    num = (jnp.einsum('bhcjs,bhcse->bhcje', s, vc)
           + w_inter[..., None] * jnp.einsum('bhcjd,bhcde->bhcje', qc, c0))
    den = jnp.sum(s, axis=-1) + w_inter * jnp.einsum('bhcjd,bhcd->bhcj', qc, n0)
    h = num / jnp.maximum(jnp.abs(den), jnp.exp(-m_j))[..., None]
    return h.reshape(bsz, nh, t, -1)


def mlstm_direction(q, k, v, li, lf, state0):
    starts, _ = mlstm_states(k, v, li, lf, state0)
    return mlstm_outputs(q, k, v, li, lf, starts)


def state_inputs(p):
    k = to_heads(p[..., OFF_K:OFF_V], DH_QK)
    v = to_heads(p[..., OFF_V:OFF_GATE], DH_V)
    gates = p[..., OFF_GATE:N_STATE_COLS].astype(jnp.float32)
    bsz, t, _ = gates.shape
    gates = gates.reshape(bsz, t, 4, N_HEADS).transpose(2, 0, 3, 1)
    fwd = (gates[0], jax.nn.log_sigmoid(gates[1]))
    bwd = (gates[2], jax.nn.log_sigmoid(gates[3]))
    return k, v, fwd, bwd


def depthwise_conv(u, w, pad_h, pad_w):
    return lax.conv_general_dilated(u, w.astype(u.dtype), (1, 1), (pad_h, pad_w),
                                    dimension_numbers=('NHWC', 'HWIO', 'NHWC'),
                                    feature_group_count=u.shape[-1])


def depthwise_conv_grid(u, w):
    bsz, t, ch = u.shape
    rows = t // GRID_W
    half = ch // 2
    grid = u.reshape(bsz, rows, GRID_W, ch)
    yh = depthwise_conv(grid[..., :half], w[:, :half].reshape(1, CONV_W, 1, half), (0, 0), (CONV_PAD, CONV_PAD))
    yv = depthwise_conv(grid[..., half:], w[:, half:].reshape(CONV_W, 1, 1, ch - half), (CONV_PAD, CONV_PAD), (0, 0))
    return jnp.concatenate([yh, yv], axis=-1).reshape(bsz, t, ch)


def depthwise_conv_tokens(u, w):
    ch = u.shape[-1]
    y = depthwise_conv(u[:, None], w.reshape(1, CONV_W, 1, ch), (0, 0), (CONV_PAD, CONV_PAD))
    return y[:, 0]


def hybrid_layer(x, ctx, c, c_ctx, w_ada, b_ada, w_in, b_in, mh_ln_g, conv_w, conv_b,
                 conv_ln_g, conv_ln_b, w_m_out, w_c_out, w_o, ffn1_w13, ffn1_w2,
                 ffn2_w13, ffn2_w2, post_ln_g, post_ln_b, ctx_out):
    bsz = x.shape[0]
    mod_x = (jax.nn.silu(c) @ w_ada + b_ada).reshape(bsz, 3, 3, D_MODEL)
    mod_c = (jax.nn.silu(c_ctx) @ w_ada + b_ada).reshape(1, 3, 3, D_MODEL)

    def mod_in(h, sub, mod):
        return h * (1.0 + mod[:, sub, 1][:, None]) + mod[:, sub, 0][:, None]

    def residual(h, sub, out, mod, weight):
        gate = mod[:, sub, 2][:, None]
        return layer_norm(DEEPNORM_ALPHA * h + weight * gate * out, post_ln_g[sub], post_ln_b[sub])

    def mlstm_finish(h, o):
        t = h.shape[2]
        h = layer_norm(h.transpose(0, 2, 1, 3), mh_ln_g.reshape(N_HEADS, DH_V))
        h = h.reshape(h.shape[0], t, D_V).astype(o.dtype) * jax.nn.sigmoid(o)
        return h @ w_m_out

    def conv_module(glu, grid):
        a, g = jnp.split(glu, 2, axis=-1)
        u = a * jax.nn.sigmoid(g)
        y = depthwise_conv_grid(u, conv_w) if grid else depthwise_conv_tokens(u, conv_w)
        y = layer_norm(y + conv_b, conv_ln_g, conv_ln_b)
        return jax.nn.silu(y) @ w_c_out

    def merge(p, y_m, y_c):
        g_m, g_c = jnp.split(p[..., OFF_MERGE:], 2, axis=-1)
        return (jax.nn.sigmoid(g_m) * y_m + jax.nn.sigmoid(g_c) * y_c) @ w_o

    x = residual(x, 0, swiglu(mod_in(x, 0, mod_x), ffn1_w13, ffn1_w2), mod_x, FFN_RES_WEIGHT)
    ctx = residual(ctx, 0, swiglu(mod_in(ctx, 0, mod_c), ffn1_w13, ffn1_w2), mod_c, FFN_RES_WEIGHT)

    hx = mod_in(x, 1, mod_x)
    hc = mod_in(ctx, 1, mod_c)
    px = hx @ w_in + b_in
    if ctx_out:
        pc = hc @ w_in + b_in
    else:
        pc = hc @ w_in[:, :N_STATE_COLS] + b_in[:N_STATE_COLS]

    kc, vc, (li_cf, lf_cf), (li_cb, lf_cb) = state_inputs(pc)
    zero = zero_state(bsz)
    st_cf, fin_cf = mlstm_states(kc, vc, li_cf, lf_cf, zero)
    st_cb, fin_cb = mlstm_states(flip_t(kc), flip_t(vc), flip_t(li_cb), flip_t(lf_cb), zero)

    kx, vx, (li_xf, lf_xf), (li_xb, lf_xb) = state_inputs(px)
    qx = to_heads(px[..., OFF_Q:OFF_O], DH_QK) * (DH_QK ** -0.5)
    h_x = (mlstm_direction(qx, kx, vx, li_xf, lf_xf, fin_cf)
           + flip_t(mlstm_direction(flip_t(qx), flip_t(kx), flip_t(vx), flip_t(li_xb), flip_t(lf_xb), fin_cb)))
    y_m = mlstm_finish(h_x, px[..., OFF_O:OFF_GLU])
    y_c = conv_module(px[..., OFF_GLU:OFF_MERGE], True)
    x = residual(x, 1, merge(px, y_m, y_c), mod_x, 1.0)

    if ctx_out:
        qc = to_heads(pc[..., OFF_Q:OFF_O], DH_QK) * (DH_QK ** -0.5)
        h_c = (mlstm_outputs(qc, kc, vc, li_cf, lf_cf, st_cf)
               + flip_t(mlstm_outputs(flip_t(qc), flip_t(kc), flip_t(vc), flip_t(li_cb), flip_t(lf_cb), st_cb)))
        yc_m = mlstm_finish(h_c, pc[..., OFF_O:OFF_GLU])
        yc_c = conv_module(pc[..., OFF_GLU:OFF_MERGE], False)
        ctx = residual(ctx, 1, merge(pc, yc_m, yc_c), mod_c, 1.0)

    x = residual(x, 2, swiglu(mod_in(x, 2, mod_x), ffn2_w13, ffn2_w2), mod_x, FFN_RES_WEIGHT)
    if ctx_out:
        ctx = residual(ctx, 2, swiglu(mod_in(ctx, 2, mod_c), ffn2_w13, ffn2_w2), mod_c, FFN_RES_WEIGHT)
        return x, ctx
    return x, None


def setup_inputs(seed: int = 0) -> dict:
    key = jax.random.key(seed)
    ks = jax.random.split(key, 24)

    def nrm(k, shape, scale):
        return jax.random.normal(k, shape, jnp.float32) * scale

    beta = DEEPNORM_BETA
    x = nrm(ks[0], (BATCH, SEQ, D_MODEL), 1.0)
    c = nrm(ks[1], (BATCH, D_MODEL), 1.0)
    ctx = nrm(ks[2], (BATCH, CTX_LEN, D_MODEL), 1.0)
    c_ctx = nrm(ks[3], (D_MODEL,), 1.0)
    w_ada = nrm(ks[4], (DEPTH, D_MODEL, 9 * D_MODEL), D_MODEL ** -0.5)
    b_ada = nrm(ks[5], (DEPTH, 9 * D_MODEL), 0.02)
    col_scale = jnp.concatenate([jnp.ones((OFF_V,), jnp.float32),
                                 jnp.full((D_V,), beta, jnp.float32),
                                 jnp.ones((N_IN - OFF_GATE,), jnp.float32)])
    w_in = nrm(ks[6], (DEPTH, D_MODEL, N_IN), D_MODEL ** -0.5) * col_scale
    f_bias = jnp.linspace(3.0, 6.0, N_HEADS, dtype=jnp.float32)
    gate_bias = jnp.concatenate([jnp.zeros((N_HEADS,), jnp.float32), f_bias,
                                 jnp.zeros((N_HEADS,), jnp.float32), f_bias])
    b_in = nrm(ks[7], (DEPTH, N_IN), 0.02).at[:, OFF_GATE:N_STATE_COLS].add(gate_bias)
    mh_ln_g = 1.0 + nrm(ks[8], (DEPTH, D_V), 0.02)
    conv_w = nrm(ks[9], (DEPTH, CONV_W, D_CONV), CONV_W ** -0.5)
    conv_b = nrm(ks[10], (DEPTH, D_CONV), 0.02)
    conv_ln_g = 1.0 + nrm(ks[11], (DEPTH, D_CONV), 0.02)
    conv_ln_b = nrm(ks[12], (DEPTH, D_CONV), 0.02)
    w_m_out = nrm(ks[13], (DEPTH, D_V, D_MODEL), D_V ** -0.5 * beta)
    w_c_out = nrm(ks[14], (DEPTH, D_CONV, D_MODEL), D_CONV ** -0.5 * beta)
    w_o = nrm(ks[15], (DEPTH, D_MODEL, D_MODEL), D_MODEL ** -0.5 * beta)
    ffn1_w13 = nrm(ks[16], (DEPTH, D_MODEL, 2 * D_FF), D_MODEL ** -0.5 * beta)
    ffn1_w2 = nrm(ks[17], (DEPTH, D_FF, D_MODEL), D_FF ** -0.5 * beta)
    ffn2_w13 = nrm(ks[18], (DEPTH, D_MODEL, 2 * D_FF), D_MODEL ** -0.5 * beta)
    ffn2_w2 = nrm(ks[19], (DEPTH, D_FF, D_MODEL), D_FF ** -0.5 * beta)
    post_ln_g = 1.0 + nrm(ks[20], (DEPTH, 3, D_MODEL), 0.02)
    post_ln_b = nrm(ks[21], (DEPTH, 3, D_MODEL), 0.02)
    return {'x': x, 'c': c, 'ctx': ctx, 'c_ctx': c_ctx, 'w_ada': w_ada, 'b_ada': b_ada,
            'w_in': w_in, 'b_in': b_in, 'mh_ln_g': mh_ln_g, 'conv_w': conv_w, 'conv_b': conv_b,
            'conv_ln_g': conv_ln_g, 'conv_ln_b': conv_ln_b, 'w_m_out': w_m_out, 'w_c_out': w_c_out,
            'w_o': w_o, 'ffn1_w13': ffn1_w13, 'ffn1_w2': ffn1_w2, 'ffn2_w13': ffn2_w13,
            'ffn2_w2': ffn2_w2, 'post_ln_g': post_ln_g, 'post_ln_b': post_ln_b}


def reference(x, c, ctx, c_ctx, w_ada, b_ada, w_in, b_in, mh_ln_g, conv_w, conv_b, conv_ln_g,
              conv_ln_b, w_m_out, w_c_out, w_o, ffn1_w13, ffn1_w2, ffn2_w13, ffn2_w2,
              post_ln_g, post_ln_b):
    for l in range(DEPTH):
        x, ctx = hybrid_layer(x, ctx, c, c_ctx, w_ada[l], b_ada[l], w_in[l], b_in[l], mh_ln_g[l],
                              conv_w[l], conv_b[l], conv_ln_g[l], conv_ln_b[l], w_m_out[l],
                              w_c_out[l], w_o[l], ffn1_w13[l], ffn1_w2[l], ffn2_w13[l], ffn2_w2[l],
                              post_ln_g[l], post_ln_b[l], l < DEPTH - 1)
    return x
```

```cpp
#include <hip/hip_runtime.h>
#include <hip/hip_cooperative_groups.h>
#include <cstdio>
#include <cstdint>
namespace cg = cooperative_groups;
namespace pg8 {
#define PG8_LAS __attribute__((address_space(3)))
typedef unsigned short bf16_t;
typedef short bf16x8 __attribute__((ext_vector_type(8)));
typedef float f32x4 __attribute__((ext_vector_type(4)));
typedef unsigned u32x4 __attribute__((ext_vector_type(4)));
constexpr int BM = 256, BK = 64, HALF = 128, HTB = HALF * BK * 2  , STAGE_BYTES = 8 * HTB, NXCD = 8, WGM = 8;

__host__ __device__ __forceinline__ int lds_byte(int r, int c) { const int st = (r >> 4) * 2 + (c >> 5), rr = r & 15, cc = c & 31, ob = rr * 64 + cc * 2; return st * 1024 + (ob ^ (((ob >> 9) & 1) << 5)); }
__host__ __device__ __forceinline__ void stage_rc(int b, int& R, int& C) { const int st = b / 1024, sb = b % 1024, swz = sb ^ (((sb >> 9) & 1) << 5); R = (st >> 1) * 16 + swz / 64; C = (st & 1) * 32 + (swz % 64) / 2; }
__host__ __device__ __forceinline__ int perm32(int rho) { const int n = rho >> 4, i = rho & 15; return 8 * (i >> 2) + 4 * n + (i & 3); }

struct Unit { int pm, pn; };
struct Gemm { const bf16_t* A; const bf16_t* Bt; int M, N, K; };

struct StaticOrder {
    int nM, nN, nwg, G, c;
    __host__ __device__ void init(int M, int N, int G_, int c_) { nM = M / BM; nN = N / BM; nwg = nM * nN; G = G_; c = c_; }
    __host__ __device__ bool next(int i, Unit& u) const {
        const long L = (long)i * G + c; if (L >= nwg) return false;
        int wgid = (int)L; { const int q = nwg / NXCD, r = nwg % NXCD, xcd = wgid % NXCD, off = wgid / NXCD; wgid = (xcd < r ? xcd * (q + 1) : r * (q + 1) + (xcd - r) * q) + off; }
        const int nig = WGM * nN, gid = wgid / nig, fm = gid * WGM, gsz = (nM - fm) < WGM ? (nM - fm) : WGM;
        u.pm = fm + ((wgid % nig) % gsz); u.pn = (wgid % nig) / gsz; return true;
    }
    __device__ __forceinline__ void a_ready(const Unit&) const {}
    __device__ __forceinline__ void done(const Unit&) const {}
};
__device__ __forceinline__ unsigned cvt_pk_bf16(float lo, float hi) { unsigned r; asm volatile("v_cvt_pk_bf16_f32 %0, %1, %2" : "=v"(r) : "v"(lo), "v"(hi)); return r; }
typedef float f32x2 __attribute__((ext_vector_type(2)));
template <class Epi, class Sched, bool ALIGN_EPI = false, bool SP2 = false>
__device__ __forceinline__ void gemm_phase(PG8_LAS unsigned char* lds, const Gemm g, const Sched& S, const Epi& E) {
    const int tid = threadIdx.x, wid = __builtin_amdgcn_readfirstlane(tid >> 6), lane = tid & 63, wr = wid >> 2, wc = wid & 3, fr = lane & 15, fq = lane >> 4;
    const int K = g.K, nt = K / BK;
    unsigned voffA[2], voffB[2];
#pragma unroll
    for (int i = 0; i < 2; ++i) { int R, C; stage_rc(tid * 16 + i * 8192, R, C); const int Rb = Epi::PERM ? ((R & ~31) + perm32(R & 31)) : R;
        voffA[i] = (unsigned)(R * K + C) * 2u; voffB[i] = (unsigned)(Rb * K + C) * 2u; }
    const size_t kstep = (size_t)(BK * 2);
    const size_t hstep = (size_t)HALF * K * 2;
    const size_t tstep = 2 * hstep;
    const unsigned ldsw = (unsigned)wid * 1024u;
    const int aoff = lds_byte(wr * 64 + fr, fq * 8), boff = lds_byte(wc * 32 + fr, fq * 8);
#define PG8_SA(b, h) (((b) * 2 + (h)) * HTB)
#define PG8_SB(b, h) ((4 + (b) * 2 + (h)) * HTB)
#define PG8_STAGE(bufoff, gbase, voff) do { _Pragma("unroll") for (int _i = 0; _i < 2; ++_i) \
        __builtin_amdgcn_global_load_lds((const unsigned*)((const char*)(gbase) + (voff)[_i]), (PG8_LAS unsigned*)(lds + (bufoff) + ldsw + _i * 8192), 16, 0, 0); } while (0)
#define PG8_LDA(dst, b, h) do { _Pragma("unroll") for (int m = 0; m < 4; ++m) _Pragma("unroll") for (int k = 0; k < 2; ++k) dst[m][k] = *(const PG8_LAS bf16x8*)(lds + PG8_SA(b, h) + aoff + m * 2048 + k * 1024); } while (0)
#define PG8_LDB(dst, b, h) do { _Pragma("unroll") for (int n = 0; n < 2; ++n) _Pragma("unroll") for (int k = 0; k < 2; ++k) dst[n][k] = *(const PG8_LAS bf16x8*)(lds + PG8_SB(b, h) + boff + n * 2048 + k * 1024); } while (0)
#define PG8_MMA(ai, bj, At, Bt) do { __builtin_amdgcn_s_setprio(1); _Pragma("unroll") for (int m = 0; m < 4; ++m) _Pragma("unroll") for (int n = 0; n < 2; ++n) _Pragma("unroll") for (int k = 0; k < 2; ++k) \
        acc[ai][bj][m][n] = __builtin_amdgcn_mfma_f32_16x16x32_bf16(Bt[n][k], At[m][k], acc[ai][bj][m][n], 0, 0, 0); __builtin_amdgcn_s_setprio(0); } while (0)
#define PG8_WAIT_V(n) asm volatile("s_waitcnt vmcnt(" #n ")" ::: "memory")
#define PG8_WAIT_L(n) asm volatile("s_waitcnt lgkmcnt(" #n ")" ::: "memory")
#define PG8_BAR __builtin_amdgcn_s_barrier()
#define PG8_SCHED __builtin_amdgcn_sched_barrier(0)
    Unit cur, nxt; int ui = 0;
    if (!S.next(0, cur)) return;
    f32x4 acc[2][2][4][2];
#pragma unroll
    for (int a = 0; a < 2; ++a)
#pragma unroll
        for (int b = 0; b < 2; ++b)
#pragma unroll
            for (int m = 0; m < 4; ++m)
#pragma unroll
                for (int n = 0; n < 2; ++n) acc[a][b][m][n] = (f32x4){0.f, 0.f, 0.f, 0.f};
    bf16x8 At[4][2], B0[2][2], B1[2][2];
    const char* cA = (const char*)g.A + (size_t)cur.pm * tstep; const char* cB = (const char*)g.Bt + (size_t)cur.pn * tstep;
    S.a_ready(cur);
    if constexpr (SP2) {
        PG8_STAGE(PG8_SB(0, 0), cB, voffB); PG8_STAGE(PG8_SB(0, 1), cB + hstep, voffB); PG8_STAGE(PG8_SA(0, 0), cA, voffA); PG8_STAGE(PG8_SA(0, 1), cA + hstep, voffA);
        if (wr == 1) PG8_BAR;
        PG8_WAIT_V(2); PG8_BAR;
        PG8_STAGE(PG8_SB(1, 0), cB + kstep, voffB); PG8_STAGE(PG8_SA(1, 0), cA + kstep, voffA); PG8_STAGE(PG8_SB(1, 1), cB + hstep + kstep, voffB);
        PG8_WAIT_V(6); PG8_BAR;
    } else {
        PG8_STAGE(PG8_SB(0, 0), cB, voffB); PG8_STAGE(PG8_SA(0, 0), cA, voffA); PG8_STAGE(PG8_SB(0, 1), cB + hstep, voffB); PG8_STAGE(PG8_SA(0, 1), cA + hstep, voffA);
        if (wr == 1) PG8_BAR;
        PG8_WAIT_V(4); PG8_BAR;
        PG8_STAGE(PG8_SB(1, 0), cB + kstep, voffB); PG8_STAGE(PG8_SA(1, 0), cA + kstep, voffA); PG8_STAGE(PG8_SB(1, 1), cB + hstep + kstep, voffB);
        PG8_WAIT_V(6); PG8_BAR;
    }
    for (;;) {
        const bool has_next = S.next(ui + 1, nxt);
        const char* nA = has_next ? (const char*)g.A + (size_t)nxt.pm * tstep : cA; const char* nB = has_next ? (const char*)g.Bt + (size_t)nxt.pn * tstep : cB;
        for (int t = 0; t < nt; t += 2) {
            const bool last = (t == nt - 2);
            const char* a1 = cA + (size_t)(t + 1) * kstep;
            const char* a2 = last ? nA : cA + (size_t)(t + 2) * kstep; const char* b2 = last ? nB : cB + (size_t)(t + 2) * kstep;
            const char* a3 = a2 + kstep; const char* b3 = b2 + kstep;
            if (last && has_next) S.a_ready(nxt);
            if constexpr (SP2) {
            PG8_LDB(B0, 0, 0); PG8_LDB(B1, 0, 1); PG8_SCHED; PG8_LDA(At, 0, 0); PG8_STAGE(PG8_SA(1, 1), a1 + hstep, voffA);
            PG8_WAIT_V(8); PG8_WAIT_L(0); PG8_BAR; PG8_MMA(0, 0, At, B0); PG8_MMA(0, 1, At, B1); PG8_BAR; PG8_SCHED;
            PG8_LDA(At, 0, 1); PG8_STAGE(PG8_SB(0, 0), b2, voffB); PG8_STAGE(PG8_SB(0, 1), b2 + hstep, voffB); PG8_STAGE(PG8_SA(0, 0), a2, voffA);
            PG8_WAIT_V(8); PG8_WAIT_L(0); PG8_BAR; PG8_MMA(1, 0, At, B0); PG8_MMA(1, 1, At, B1); PG8_BAR; PG8_SCHED;
            PG8_LDB(B0, 1, 0); PG8_LDB(B1, 1, 1); PG8_SCHED; PG8_LDA(At, 1, 0); PG8_STAGE(PG8_SA(0, 1), a2 + hstep, voffA);
            PG8_WAIT_V(8); PG8_WAIT_L(0); PG8_BAR; PG8_MMA(0, 0, At, B0); PG8_MMA(0, 1, At, B1); PG8_BAR; PG8_SCHED;
            PG8_LDA(At, 1, 1); PG8_STAGE(PG8_SB(1, 0), b3, voffB); PG8_STAGE(PG8_SB(1, 1), b3 + hstep, voffB); PG8_STAGE(PG8_SA(1, 0), a3, voffA);
            PG8_WAIT_V(8); PG8_WAIT_L(0); PG8_BAR; PG8_MMA(1, 0, At, B0); PG8_MMA(1, 1, At, B1); PG8_BAR; PG8_SCHED;
            } else {
            PG8_LDB(B0, 0, 0); PG8_SCHED; PG8_LDA(At, 0, 0); PG8_STAGE(PG8_SA(1, 1), a1 + hstep, voffA);
            PG8_WAIT_L(8); PG8_BAR; PG8_WAIT_L(0); PG8_MMA(0, 0, At, B0); PG8_BAR; PG8_SCHED;
            PG8_LDB(B1, 0, 1); PG8_STAGE(PG8_SB(0, 0), b2, voffB);
            PG8_BAR; PG8_WAIT_L(0); PG8_MMA(0, 1, At, B1); PG8_BAR;
            PG8_LDA(At, 0, 1); PG8_STAGE(PG8_SA(0, 0), a2, voffA);
            PG8_BAR; PG8_WAIT_L(0); PG8_MMA(1, 0, At, B0); PG8_BAR; PG8_SCHED;
            PG8_STAGE(PG8_SB(0, 1), b2 + hstep, voffB);
            PG8_WAIT_V(6); PG8_BAR; PG8_MMA(1, 1, At, B1); PG8_BAR;
            PG8_LDB(B0, 1, 0); PG8_SCHED; PG8_LDA(At, 1, 0); PG8_STAGE(PG8_SA(0, 1), a2 + hstep, voffA);
            PG8_WAIT_L(8); PG8_BAR; PG8_WAIT_L(0); PG8_MMA(0, 0, At, B0); PG8_BAR; PG8_SCHED;
            PG8_LDB(B1, 1, 1); PG8_STAGE(PG8_SB(1, 0), b3, voffB);
            PG8_BAR; PG8_WAIT_L(0); PG8_MMA(0, 1, At, B1); PG8_BAR;
            PG8_LDA(At, 1, 1); PG8_STAGE(PG8_SA(1, 0), a3, voffA);
            PG8_BAR; PG8_WAIT_L(0); PG8_MMA(1, 0, At, B0); PG8_BAR; PG8_SCHED;
            PG8_STAGE(PG8_SB(1, 1), b3 + hstep, voffB);
            PG8_WAIT_V(6); PG8_BAR; PG8_MMA(1, 1, At, B1); PG8_BAR;
            }
        }
        if constexpr (ALIGN_EPI) { if (wr == 0) PG8_BAR; }
        if constexpr (!Epi::AFTER_DRAIN) { E(acc, cur, wr, wc, fr, fq); S.done(cur); }
        if (!has_next) break;
#pragma unroll
        for (int a = 0; a < 2; ++a)
#pragma unroll
            for (int b = 0; b < 2; ++b)
#pragma unroll
                for (int m = 0; m < 4; ++m)
#pragma unroll
                    for (int n = 0; n < 2; ++n) acc[a][b][m][n] = (f32x4){0.f, 0.f, 0.f, 0.f};
        cur = nxt; cA = nA; cB = nB; ++ui;
        if constexpr (ALIGN_EPI) { if (wr == 1) PG8_BAR; }
    }
    PG8_WAIT_V(0);
    if constexpr (!ALIGN_EPI) { if (wr == 0) PG8_BAR; }
    PG8_BAR;
    if constexpr (Epi::AFTER_DRAIN) { E.fused(acc, cur, wr, wc, fr, fq, lds, wid, lane); S.done(cur); }
#undef PG8_SA
#undef PG8_SB
#undef PG8_STAGE
#undef PG8_LDA
#undef PG8_LDB
#undef PG8_MMA
#undef PG8_WAIT_V
#undef PG8_WAIT_L
#undef PG8_BAR
#undef PG8_SCHED
}
}

using pg8::f32x4; using pg8::bf16x8; using pg8::u32x4; using pg8::bf16_t;
#define LAS __attribute__((address_space(3)))
typedef unsigned u32x2 __attribute__((ext_vector_type(2)));
typedef float f32x2v __attribute__((ext_vector_type(2)));

constexpr int D = 2048, SEQ = 4096, MX = 8192, MC = 512, MT = 8704, CTXL = 256;
constexpr int NH = 8, DQK = 1024, DV = 2048, DCONV = 1024, DFF = 5632;
constexpr int NINP = 12544;
constexpr float LN_EPS = 1e-5f, ALPHA = 1.189207115002721f  , QSCALE = 0.08838834764831845f;
constexpr int NWAVES = 8, NTHREADS = 512;

constexpr size_t MiB = 1u << 20;
constexpr size_t WS_MOD = 4096, WS_BPERM = 512 * 1024;
constexpr size_t WS_W13A = 1 * MiB, WS_W2A = 45 * MiB, WS_WIN = 67 * MiB, WS_WM = 116 * MiB, WS_WC = 124 * MiB, WS_WO = 128 * MiB, WS_W13B = 136 * MiB, WS_W2B = 180 * MiB;
constexpr size_t WS_ACTA = 202 * MiB, WS_HBUF = 236 * MiB, WS_OBUF = 330 * MiB;
constexpr size_t WS_KB = 402 * MiB, WS_VB = 419 * MiB, WS_QB = 453 * MiB, WS_OB = 469 * MiB, WS_UB = 501 * MiB, WS_GM = 517 * MiB, WS_GC = 549 * MiB, WS_GATES = 581 * MiB, WS_AC = 583 * MiB;
constexpr size_t WS_END = 599 * MiB;

constexpr int LDS_BYTES = 135168;

__device__ __forceinline__ float bf2f(unsigned b) { return __uint_as_float(b << 16); }
__device__ __forceinline__ float bflo(unsigned w) { return __uint_as_float(w << 16); }
__device__ __forceinline__ float bfhi(unsigned w) { return __uint_as_float(w & 0xffff0000u); }
__device__ __forceinline__ unsigned pk2(float lo, float hi) { return pg8::cvt_pk_bf16(lo, hi); }
__device__ __forceinline__ float sigm(float x) { return __builtin_amdgcn_rcpf(1.f + __expf(-x)); }
__device__ __forceinline__ float wsum(float v) {
#pragma unroll
    for (int o = 32; o >= 1; o >>= 1) v += __shfl_xor(v, o);
    return v;
}

struct Frame {
    const float *x, *c, *ctx, *c_ctx, *w_ada, *b_ada, *w_in, *b_in, *mh_g, *conv_w, *conv_b, *conv_g, *conv_bb, *w_m, *w_c, *w_o, *f1w13, *f1w2, *f2w13, *f2w2, *pg, *pb;
    float* out; unsigned char* ws;
    float *mod, *bperm, *OBUF, *GATES;
    bf16_t *W13A, *W2A, *WIN, *WM, *WC, *WO, *W13B, *W2B, *ACTA, *HBUF, *KB, *VB, *QB, *OB, *UB, *GM, *GC, *AC;
};

struct EpiSwiGLU {
    static constexpr bool PERM = true, AFTER_DRAIN = false;
    bf16_t* H;
    __device__ __forceinline__ void operator()(const f32x4 (&acc)[2][2][4][2], const pg8::Unit& u, int wr, int wc, int fr, int fq) const {
        const int row0 = u.pm * 256 + wr * 64 + fr, col0 = u.pn * 128 + wc * 32 + 8 * fq;
#pragma unroll
        for (int ai = 0; ai < 2; ++ai)
#pragma unroll
            for (int m = 0; m < 4; ++m) {
                bf16_t* p = H + (size_t)(row0 + ai * 128 + m * 16) * DFF + col0;
                float h[8];
#pragma unroll
                for (int n = 0; n < 2; ++n)
#pragma unroll
                    for (int j = 0; j < 4; ++j) { const float a = acc[ai][0][m][n][j], g = acc[ai][1][m][n][j]; h[n * 4 + j] = a * sigm(a) * g; }
                u32x4 w; w.x = pk2(h[0], h[1]); w.y = pk2(h[2], h[3]); w.z = pk2(h[4], h[5]); w.w = pk2(h[6], h[7]);
                *(u32x4*)p = w;
            }
    }
};
struct EpiF32 {
    static constexpr bool PERM = false, AFTER_DRAIN = false;
    float* C;
    __device__ __forceinline__ void operator()(const f32x4 (&acc)[2][2][4][2], const pg8::Unit& u, int wr, int wc, int fr, int fq) const {
        const int row0 = u.pm * 256 + wr * 64 + fr, col0 = u.pn * 256 + wc * 32 + 4 * fq;
#pragma unroll
        for (int ai = 0; ai < 2; ++ai)
#pragma unroll
            for (int m = 0; m < 4; ++m) { float* rowp = C + (size_t)(row0 + ai * 128 + m * 16) * D + col0;
#pragma unroll
                for (int bj = 0; bj < 2; ++bj)
#pragma unroll
                    for (int n = 0; n < 2; ++n) *(f32x4*)(rowp + bj * 128 + n * 16) = acc[ai][bj][m][n]; }
    }
};
struct EpiGateT {
    static constexpr bool PERM = false, AFTER_DRAIN = false;
    float* T; const bf16_t* G;
    __device__ __forceinline__ void operator()(const f32x4 (&acc)[2][2][4][2], const pg8::Unit& u, int wr, int wc, int fr, int fq) const {
        const int row0 = u.pm * 256 + wr * 64 + fr, col0 = u.pn * 256 + wc * 32 + 4 * fq;
#pragma unroll
        for (int ai = 0; ai < 2; ++ai)
#pragma unroll
            for (int m = 0; m < 4; ++m) { const size_t ro = (size_t)(row0 + ai * 128 + m * 16) * D + col0;
#pragma unroll
                for (int bj = 0; bj < 2; ++bj)
#pragma unroll
                    for (int n = 0; n < 2; ++n) { const size_t o = ro + bj * 128 + n * 16; const u32x2 gv = *(const u32x2*)(G + o); const f32x4 a = acc[ai][bj][m][n];
                        f32x4 r; r[0] = a[0] * bflo(gv.x); r[1] = a[1] * bfhi(gv.x); r[2] = a[2] * bflo(gv.y); r[3] = a[3] * bfhi(gv.y); *(f32x4*)(T + o) = r; } }
    }
};
struct EpiMerge {
    static constexpr bool PERM = false, AFTER_DRAIN = false;
    const float* T; const bf16_t* G; bf16_t* O;
    __device__ __forceinline__ void operator()(const f32x4 (&acc)[2][2][4][2], const pg8::Unit& u, int wr, int wc, int fr, int fq) const {
        const int row0 = u.pm * 256 + wr * 64 + fr, col0 = u.pn * 256 + wc * 32 + 4 * fq;
#pragma unroll
        for (int ai = 0; ai < 2; ++ai)
#pragma unroll
            for (int m = 0; m < 4; ++m) { const size_t ro = (size_t)(row0 + ai * 128 + m * 16) * D + col0;
#pragma unroll
                for (int bj = 0; bj < 2; ++bj)
#pragma unroll
                    for (int n = 0; n < 2; ++n) { const size_t o = ro + bj * 128 + n * 16; const u32x2 gv = *(const u32x2*)(G + o); const f32x4 t = *(const f32x4*)(T + o); const f32x4 a = acc[ai][bj][m][n];
                        u32x2 w; w.x = pk2(a[0] * bflo(gv.x) + t[0], a[1] * bfhi(gv.x) + t[1]); w.y = pk2(a[2] * bflo(gv.y) + t[2], a[3] * bfhi(gv.y) + t[3]); *(u32x2*)(O + o) = w; } }
    }
};
struct EpiInProj {
    static constexpr bool PERM = true, AFTER_DRAIN = false;
    const float* bias; bf16_t *KB, *VB, *QB, *OB, *UB, *GM, *GC; float* GATES;
    __device__ __forceinline__ void operator()(const f32x4 (&acc)[2][2][4][2], const pg8::Unit& u, int wr, int wc, int fr, int fq) const {
        const int pn = u.pn, row0 = u.pm * 256 + wr * 64 + fr, lc0 = wc * 32 + 8 * fq;
        if (pn == 48) {
            if (wc == 0) {
                const f32x4 b0 = *(const f32x4*)(bias + 12288 + 8 * fq), b1 = *(const f32x4*)(bias + 12288 + 8 * fq + 4);
#pragma unroll
                for (int ai = 0; ai < 2; ++ai)
#pragma unroll
                    for (int m = 0; m < 4; ++m) { float* p = GATES + (size_t)(row0 + ai * 128 + m * 16) * 32 + 8 * fq;
                        *(f32x4*)p = acc[ai][0][m][0] + b0; *(f32x4*)(p + 4) = acc[ai][0][m][1] + b1; }
            }
            return;
        }
        if (pn >= 24 && pn < 32) {
            const int col = (pn - 24) * 128 + lc0;
            const f32x4 ba0 = *(const f32x4*)(bias + pn * 256 + lc0), ba1 = *(const f32x4*)(bias + pn * 256 + lc0 + 4);
            const f32x4 bg0 = *(const f32x4*)(bias + pn * 256 + 128 + lc0), bg1 = *(const f32x4*)(bias + pn * 256 + 128 + lc0 + 4);
#pragma unroll
            for (int ai = 0; ai < 2; ++ai)
#pragma unroll
                for (int m = 0; m < 4; ++m) {
                    const f32x4 a0 = acc[ai][0][m][0] + ba0, a1 = acc[ai][0][m][1] + ba1, g0 = acc[ai][1][m][0] + bg0, g1 = acc[ai][1][m][1] + bg1;
                    u32x4 w; w.x = pk2(a0[0] * sigm(g0[0]), a0[1] * sigm(g0[1])); w.y = pk2(a0[2] * sigm(g0[2]), a0[3] * sigm(g0[3]));
                    w.z = pk2(a1[0] * sigm(g1[0]), a1[1] * sigm(g1[1])); w.w = pk2(a1[2] * sigm(g1[2]), a1[3] * sigm(g1[3]));
                    *(u32x4*)(UB + (size_t)(row0 + ai * 128 + m * 16) * DCONV + col) = w;
                }
            return;
        }
        bf16_t* dst; int ldc, cb, mode;
        if (pn < 4) { dst = KB; ldc = DQK; cb = pn * 256; mode = 0; }
        else if (pn < 12) { dst = VB; ldc = DV; cb = (pn - 4) * 256; mode = 0; }
        else if (pn < 16) { dst = QB; ldc = DQK; cb = (pn - 12) * 256; mode = 1; }
        else if (pn < 24) { dst = OB; ldc = DV; cb = (pn - 16) * 256; mode = 2; }
        else if (pn < 40) { dst = GM; ldc = D; cb = (pn - 32) * 256; mode = 2; }
        else { dst = GC; ldc = D; cb = (pn - 40) * 256; mode = 2; }
#pragma unroll
        for (int bj = 0; bj < 2; ++bj) {
            const f32x4 b0 = *(const f32x4*)(bias + pn * 256 + bj * 128 + lc0), b1 = *(const f32x4*)(bias + pn * 256 + bj * 128 + lc0 + 4);
#pragma unroll
            for (int ai = 0; ai < 2; ++ai)
#pragma unroll
                for (int m = 0; m < 4; ++m) {
                    f32x4 v0 = acc[ai][bj][m][0] + b0, v1 = acc[ai][bj][m][1] + b1;
                    if (mode == 1) { v0 = v0 * QSCALE; v1 = v1 * QSCALE; }
                    if (mode == 2) {
#pragma unroll
                        for (int j = 0; j < 4; ++j) { v0[j] = sigm(v0[j]); v1[j] = sigm(v1[j]); } }
                    u32x4 w; w.x = pk2(v0[0], v0[1]); w.y = pk2(v0[2], v0[3]); w.z = pk2(v1[0], v1[1]); w.w = pk2(v1[2], v1[3]);
                    *(u32x4*)(dst + (size_t)(row0 + ai * 128 + m * 16) * ldc + cb + bj * 128 + lc0) = w;
                }
        }
    }
};
struct InProjOrder {
    pg8::StaticOrder so;
    __device__ void init(int G, int c) { so.init(MX, NINP, G, c); }
    __device__ bool next(int i, pg8::Unit& u) const {
        if (so.next(i, u)) return true;
        const long L = (long)i * so.G + so.c - so.nwg; if (L >= 26) return false;
        const int j = (int)L % 13; u.pm = 32 + (int)L / 13; u.pn = j < 12 ? j : 48; return true;
    }
    __device__ __forceinline__ void a_ready(const pg8::Unit&) const {}
    __device__ __forceinline__ void done(const pg8::Unit&) const {}
};

__device__ __forceinline__ int map_col(int mode, int n) {
    if (mode == 0) return n;
    if (mode == 1) { const int t = n >> 8, i = n & 255; return i < 128 ? 128 * t + i : DFF + 128 * t + (i - 128); }
    if (n < 3072) return n;
    if (n < 4096) return 3104 + (n - 3072);
    if (n < 6144) return 4128 + (n - 4096);
    if (n < 8192) { const int t = (n - 6144) >> 8, i = (n - 6144) & 255; return i < 128 ? 6176 + 128 * t + i : 6176 + 1024 + 128 * t + (i - 128); }
    if (n < 12288) return 8224 + (n - 8192);
    if (n < 12320) return 3072 + (n - 12288);
    return -1;
}
__device__ __forceinline__ void adaln_group(const Frame& F, int grp, LAS unsigned char* lds) {
    LAS float* sc = (LAS float*)lds;
    LAS float* red = (LAS float*)(lds + 3 * 2048 * 4);
    const int tid = threadIdx.x;
    for (int i = tid; i < 3 * 2048; i += NTHREADS) { const int r = i >> 11, k = i & 2047; const float v = r < 2 ? F.c[r * 2048 + k] : F.c_ctx[k]; sc[i] = v * (1.f / (1.f + expf(-v))); }
    __syncthreads();
    const int c4 = tid % 18, kg = tid / 18, n0 = grp * 72 + c4 * 4;
    f32x4 a0 = {0.f, 0.f, 0.f, 0.f}, a1 = a0, a2 = a0;
    if (kg < 28) {
        for (int k = kg; k < 2048; k += 28) {
            const f32x4 w = *(const f32x4*)(F.w_ada + (size_t)k * (9 * D) + n0);
            a0 += w * sc[k]; a1 += w * sc[2048 + k]; a2 += w * sc[4096 + k];
        }
        LAS float* p = red + (kg * 18 + c4) * 12;
        *(LAS f32x4*)p = a0; *(LAS f32x4*)(p + 4) = a1; *(LAS f32x4*)(p + 8) = a2;
    }
    __syncthreads();
    if (tid < 216) {
        const int cc = tid / 12, e = tid % 12, r = e >> 2, j = e & 3; float s = 0.f;
        for (int g = 0; g < 28; ++g) s += red[(g * 18 + cc) * 12 + e];
        const int n = grp * 72 + cc * 4 + j;
        F.mod[r * (9 * D) + n] = s + F.b_ada[n];
    }
    __syncthreads();
}
__device__ __forceinline__ void cvt_tile(const float* W, int Nsrc, bf16_t* Bt, int K, int k0, int n0, int mode, LAS float* tile) {
    const int tid = threadIdx.x, nn = tid & 63, kk0 = tid >> 6;
    const int src = map_col(mode, n0 + nn);
#pragma unroll
    for (int p = 0; p < 8; ++p) { const int kk = p * 8 + kk0; tile[kk * 65 + nn] = src >= 0 ? W[(size_t)(k0 + kk) * Nsrc + src] : 0.f; }
    __syncthreads();
    const int rn = tid >> 3, kg = tid & 7; float v[8];
#pragma unroll
    for (int i = 0; i < 8; ++i) v[i] = tile[(kg * 8 + i) * 65 + rn];
    u32x4 w; w.x = pk2(v[0], v[1]); w.y = pk2(v[2], v[3]); w.z = pk2(v[4], v[5]); w.w = pk2(v[6], v[7]);
    *(u32x4*)(Bt + (size_t)(n0 + rn) * K + k0 + kg * 8) = w;
    __syncthreads();
}
__device__ __forceinline__ void p0_prep(const Frame& F, LAS unsigned char* lds) {
    for (int g = blockIdx.x; g < 256; g += gridDim.x) adaln_group(F, g, lds);
    for (int i = blockIdx.x * NTHREADS + threadIdx.x; i < NINP; i += gridDim.x * NTHREADS) { const int s = map_col(2, i); F.bperm[i] = s >= 0 ? F.b_in[s] : 0.f; }
    constexpr int T0 = 5632, T1 = 2816, T2 = 6272, T3 = 1024, T4 = 512, T5 = 1024, T6 = 5632, T7 = 2816, TT = T0 + T1 + T2 + T3 + T4 + T5 + T6 + T7;
    for (int T = blockIdx.x; T < TT; T += gridDim.x) {
        int t = T; const float* W; bf16_t* Bt; int Nsrc, K, Np, mode;
        if (t < T0) { W = F.f1w13; Bt = F.W13A; Nsrc = 2 * DFF; K = D; Np = 2 * DFF; mode = 1; }
        else if ((t -= T0) < T1) { W = F.f1w2; Bt = F.W2A; Nsrc = D; K = DFF; Np = D; mode = 0; }
        else if ((t -= T1) < T2) { W = F.w_in; Bt = F.WIN; Nsrc = 12320; K = D; Np = NINP; mode = 2; }
        else if ((t -= T2) < T3) { W = F.w_m; Bt = F.WM; Nsrc = D; K = DV; Np = D; mode = 0; }
        else if ((t -= T3) < T4) { W = F.w_c; Bt = F.WC; Nsrc = D; K = DCONV; Np = D; mode = 0; }
        else if ((t -= T4) < T5) { W = F.w_o; Bt = F.WO; Nsrc = D; K = D; Np = D; mode = 0; }
        else if ((t -= T5) < T6) { W = F.f2w13; Bt = F.W13B; Nsrc = 2 * DFF; K = D; Np = 2 * DFF; mode = 1; }
        else { t -= T6; W = F.f2w2; Bt = F.W2B; Nsrc = D; K = DFF; Np = D; mode = 0; }
        const int ntn = Np / 64, tn = t % ntn, tk = t / ntn;
        cvt_tile(W, Nsrc, Bt, K, tk * 64, tn * 64, mode, (LAS float*)lds);
    }
}

__device__ __forceinline__ void store_modin(const f32x4 (&y)[8], const float* modr, int sub, bf16_t* arow, int lane) {
    const float* shift = modr + (sub * 3 + 0) * D; const float* scale = modr + (sub * 3 + 1) * D;
#pragma unroll
    for (int i = 0; i < 8; ++i) { const int idx = (i * 64 + lane) * 4; const f32x4 s = *(const f32x4*)(scale + idx), sh = *(const f32x4*)(shift + idx);
        const f32x4 o = y[i] * (s + 1.f) + sh; u32x2 w; w.x = pk2(o[0], o[1]); w.y = pk2(o[2], o[3]); *(u32x2*)(arow + idx) = w; }
}
__device__ __forceinline__ void p_modin0(const Frame& F) {
    const int lane = threadIdx.x & 63, wv = threadIdx.x >> 6;
    for (int row = blockIdx.x * NWAVES + wv; row < MT; row += gridDim.x * NWAVES) {
        const float* src = row < MX ? F.x + (size_t)row * D : F.ctx + (size_t)(row - MX) * D;
        const int r = row < MX ? row >> 12 : 2;
        f32x4 y[8];
#pragma unroll
        for (int i = 0; i < 8; ++i) y[i] = *(const f32x4*)(src + (i * 64 + lane) * 4);
        store_modin(y, F.mod + r * 9 * D, 0, F.ACTA + (size_t)row * D, lane);
    }
}
template <int SUB> __device__ __forceinline__ void p_residual(const Frame& F, float weight, int nrows) {
    const int lane = threadIdx.x & 63, wv = threadIdx.x >> 6;
    for (int row = blockIdx.x * NWAVES + wv; row < nrows; row += gridDim.x * NWAVES) {
        const bool isx = row < MX;
        const float* xin = isx ? ((SUB == 0 ? F.x : (const float*)F.out) + (size_t)row * D) : F.ctx + (size_t)(row - MX) * D;
        const int r = isx ? row >> 12 : 2;
        const float* modr = F.mod + r * 9 * D; const float* gate = modr + (SUB * 3 + 2) * D;
        const float* orow = F.OBUF + (size_t)row * D; const float* lg = F.pg + SUB * D; const float* lb = F.pb + SUB * D;
        f32x4 v[8]; float s = 0.f;
#pragma unroll
        for (int i = 0; i < 8; ++i) { const int idx = (i * 64 + lane) * 4; const f32x4 xv = *(const f32x4*)(xin + idx), ov = *(const f32x4*)(orow + idx), gv = *(const f32x4*)(gate + idx);
            v[i] = xv * ALPHA + (gv * weight) * ov; s += (v[i][0] + v[i][1]) + (v[i][2] + v[i][3]); }
        const float mean = wsum(s) * (1.f / D); float q = 0.f;
#pragma unroll
        for (int i = 0; i < 8; ++i) { v[i] = v[i] - mean; q += (v[i][0] * v[i][0] + v[i][1] * v[i][1]) + (v[i][2] * v[i][2] + v[i][3] * v[i][3]); }
        const float rstd = rsqrtf(wsum(q) * (1.f / D) + LN_EPS);
#pragma unroll
        for (int i = 0; i < 8; ++i) { const int idx = (i * 64 + lane) * 4; v[i] = v[i] * rstd * *(const f32x4*)(lg + idx) + *(const f32x4*)(lb + idx);
            if (isx) *(f32x4*)(F.out + (size_t)row * D + idx) = v[i]; }
        if (SUB < 2) store_modin(v, modr, SUB + 1, F.ACTA + (size_t)row * D, lane);
    }
}
__device__ __forceinline__ void p_headnorm(const Frame& F, const float* HF0, const float* HF1) {
    const int lane = threadIdx.x & 63, wv = threadIdx.x >> 6;
    for (int row = blockIdx.x * NWAVES + wv; row < MX; row += gridDim.x * NWAVES) {
#pragma unroll
        for (int hh = 0; hh < NH; ++hh) {
            const size_t o = (size_t)row * DV + hh * 256 + lane * 4;
            f32x4 v = *(const f32x4*)(HF0 + o) + *(const f32x4*)(HF1 + o);
            const float mean = wsum((v[0] + v[1]) + (v[2] + v[3])) * (1.f / 256.f);
            v = v - mean;
            const float rstd = rsqrtf(wsum((v[0] * v[0] + v[1] * v[1]) + (v[2] * v[2] + v[3] * v[3])) * (1.f / 256.f) + LN_EPS);
            const f32x4 g = *(const f32x4*)(F.mh_g + hh * 256 + lane * 4); const u32x2 so = *(const u32x2*)(F.OB + o);
            v = v * rstd * g;
            u32x2 w; w.x = pk2(v[0] * bflo(so.x), v[1] * bfhi(so.x)); w.y = pk2(v[2] * bflo(so.y), v[3] * bfhi(so.y));
            *(u32x2*)(F.ACTA + o) = w;
        }
    }
}

constexpr int LP = 136;
constexpr int L_Q = 0, L_K = 34816, L_KT = 69632, L_VT = 104448, L_CT = 117504, L_ARR = 130560;
__device__ __forceinline__ float logsig(float x) { return fminf(x, 0.f) - log1pf(expf(-fabsf(x))); }
__device__ __forceinline__ int chunk_row0(int cc, int dir, int b) { if (cc < 2) { const int ci = dir ? 1 - cc : cc; return MX + b * CTXL + ci * 128; } const int xi = dir ? 33 - cc : cc - 2; return b * SEQ + xi * 128; }
__device__ __forceinline__ unsigned short hsel(const u32x4& v, int i) { const unsigned w = (i >> 1) == 0 ? v.x : (i >> 1) == 1 ? v.y : (i >> 1) == 2 ? v.z : v.w; return (unsigned short)((i & 1) ? (w >> 16) : (w & 0xffffu)); }

__device__ __forceinline__ void mlstm_unit(const Frame& F, int unit, LAS unsigned char* lds, float* HF0, float* HF1) {
    const int tid = threadIdx.x, lane = tid & 63, w = __builtin_amdgcn_readfirstlane(tid >> 6), l15 = lane & 15, q = lane >> 4;
    const int dir = unit >> 7, b = (unit >> 6) & 1, h = (unit >> 3) & 7, sl = unit & 7;
    LAS bf16_t* sQ = (LAS bf16_t*)(lds + L_Q); LAS bf16_t* sK = (LAS bf16_t*)(lds + L_K); LAS bf16_t* sKt = (LAS bf16_t*)(lds + L_KT);
    LAS bf16_t* sVt = (LAS bf16_t*)(lds + L_VT); LAS bf16_t* sCt = (LAS bf16_t*)(lds + L_CT);
    LAS float* sU = (LAS float*)(lds + L_ARR); LAS float* sM = sU + 128; LAS float* sB = sU + 256; LAS float* sW = sU + 384; LAS float* sS = sU + 512;
    float* HF = dir ? HF1 : HF0;
    for (int i = tid; i < 16 * LP; i += NTHREADS) sVt[32 * LP + i] = (i < LP) ? (bf16_t)0x3F80 : (bf16_t)0;
    for (int i = tid; i < 48 * LP; i += NTHREADS) sCt[i] = 0;
    f32x4 accC[3];
#pragma unroll
    for (int nt = 0; nt < 3; ++nt) accC[nt] = (f32x4){0.f, 0.f, 0.f, 0.f};
    float m_run = -1e4f;
    const int rg = tid >> 4, cgp = tid & 15;
    u32x4 kreg[4], qreg[4]; unsigned vreg[4]; float gi[2], gf[2];
    const int kcol = h * 128 + 8 * cgp, vcol = h * 256 + sl * 32 + 2 * cgp, gcol = dir * 16 + h;
#pragma unroll
    for (int r = 0; r < 4; ++r) qreg[r] = (u32x4){0u, 0u, 0u, 0u};
    gi[0] = gi[1] = gf[0] = gf[1] = 0.f;
#define ML_LOAD(cc) do { const int _r0 = chunk_row0((cc), dir, b); \
        _Pragma("unroll") for (int r = 0; r < 4; ++r) { const int j = 4 * rg + r; const size_t row = (size_t)(_r0 + (dir ? 127 - j : j)); \
            kreg[r] = *(const u32x4*)(F.KB + row * DQK + kcol); if ((cc) >= 2) qreg[r] = *(const u32x4*)(F.QB + row * DQK + kcol); vreg[r] = *(const unsigned*)(F.VB + row * DV + vcol); } \
        if (w == 0) { _Pragma("unroll") for (int e = 0; e < 2; ++e) { const int j = 2 * lane + e; const size_t row = (size_t)(_r0 + (dir ? 127 - j : j)); gi[e] = F.GATES[row * 32 + gcol]; gf[e] = F.GATES[row * 32 + gcol + 8]; } } } while (0)
    ML_LOAD(0);
    for (int cc = 0; cc < 34; ++cc) {
        const bool isx = cc >= 2;
        const int row0 = chunk_row0(cc, dir, b);
#pragma unroll
        for (int r = 0; r < 4; ++r) { *(LAS u32x4*)(sK + (4 * rg + r) * LP + 8 * cgp) = kreg[r]; if (isx) *(LAS u32x4*)(sQ + (4 * rg + r) * LP + 8 * cgp) = qreg[r]; }
#pragma unroll
        for (int i = 0; i < 8; ++i) { const int d = 8 * cgp + i; u32x2 wv; wv.x = (unsigned)hsel(kreg[0], i) | ((unsigned)hsel(kreg[1], i) << 16); wv.y = (unsigned)hsel(kreg[2], i) | ((unsigned)hsel(kreg[3], i) << 16);
            *(LAS u32x2*)(sKt + d * LP + 8 * ((rg >> 1) ^ (cgp & 7)) + 4 * (rg & 1)) = wv; }
#pragma unroll
        for (int i = 0; i < 2; ++i) { const int e = 2 * cgp + i; u32x2 wv;
            wv.x = (i ? (vreg[0] >> 16) : (vreg[0] & 0xffffu)) | ((i ? (vreg[1] >> 16) : (vreg[1] & 0xffffu)) << 16);
            wv.y = (i ? (vreg[2] >> 16) : (vreg[2] & 0xffffu)) | ((i ? (vreg[3] >> 16) : (vreg[3] & 0xffffu)) << 16);
            *(LAS u32x2*)(sVt + e * LP + 4 * rg) = wv; }
        if (w == 0) {
            const float lf0 = logsig(gf[0]), lf1 = logsig(gf[1]), p = lf0 + lf1; float incl = p;
#pragma unroll
            for (int o = 1; o < 64; o <<= 1) { const float t = __shfl_up(incl, o); if (lane >= o) incl += t; }
            const float b0 = incl - p + lf0, b1 = incl, u0 = gi[0] - b0, u1 = gi[1] - b1;
            float im = fmaxf(u0, u1);
#pragma unroll
            for (int o = 1; o < 64; o <<= 1) { const float t = __shfl_up(im, o); if (lane >= o) im = fmaxf(im, t); }
            float ex = __shfl_up(im, 1); if (lane == 0) ex = -INFINITY;
            const float pm0 = fmaxf(ex, u0), pm1 = fmaxf(pm0, u1);
            const float g = __shfl(b1, 63), pml = __shfl(pm1, 63);
            const float Ml = fmaxf(m_run, pml);
            sU[2 * lane] = u0; sU[2 * lane + 1] = u1; sM[2 * lane] = fmaxf(m_run, pm0); sM[2 * lane + 1] = fmaxf(m_run, pm1);
            sB[2 * lane] = b0; sB[2 * lane + 1] = b1; sW[2 * lane] = expf(u0 - Ml); sW[2 * lane + 1] = expf(u1 - Ml);
            if (lane == 0) { sS[0] = expf(m_run - Ml); sS[1] = m_run; }
            m_run = g + Ml;
        }
        if (cc + 1 < 34) ML_LOAD(cc + 1);
        __syncthreads();
        if (isx) {
            bf16x8 qf[4];
#pragma unroll
            for (int ks = 0; ks < 4; ++ks) qf[ks] = *(const LAS bf16x8*)(sQ + (16 * w + l15) * LP + 32 * ks + 8 * q);
            f32x4 accO[3];
#pragma unroll
            for (int nt = 0; nt < 3; ++nt) accO[nt] = (f32x4){0.f, 0.f, 0.f, 0.f};
#pragma unroll
            for (int ks = 0; ks < 4; ++ks)
#pragma unroll
                for (int nt = 0; nt < 3; ++nt) { const bf16x8 bfr = *(const LAS bf16x8*)(sCt + (16 * nt + l15) * LP + 32 * ks + 8 * q); accO[nt] = __builtin_amdgcn_mfma_f32_16x16x32_bf16(qf[ks], bfr, accO[nt], 0, 0, 0); }
            const float m_old = sS[1];
#pragma unroll
            for (int i = 0; i < 4; ++i) { const float wi = __expf(m_old - sM[16 * w + 4 * q + i]);
#pragma unroll
                for (int nt = 0; nt < 3; ++nt) accO[nt][i] *= wi; }
            const float Mj = sM[16 * w + l15];
            for (int mt = 0; mt <= w; ++mt) {
                f32x4 s = (f32x4){0.f, 0.f, 0.f, 0.f};
#pragma unroll
                for (int ks = 0; ks < 4; ++ks) { const bf16x8 a = *(const LAS bf16x8*)(sK + (16 * mt + l15) * LP + 32 * ks + 8 * q); s = __builtin_amdgcn_mfma_f32_16x16x32_bf16(a, qf[ks], s, 0, 0, 0); }
                const f32x4 uu = *(const LAS f32x4*)(sU + 16 * mt + 4 * q);
                float pv[4];
#pragma unroll
                for (int i = 0; i < 4; ++i) { const float e = s[i] * __expf(uu[i] - Mj); pv[i] = (mt == w && (4 * q + i) > l15) ? 0.f : e; }
                u32x2 wv; wv.x = pk2(pv[0], pv[1]); wv.y = pk2(pv[2], pv[3]);
                *(LAS u32x2*)(sQ + (16 * w + l15) * LP + 16 * mt + 4 * q) = wv;
            }
            if (!(w & 1)) { u32x2 z; z.x = 0u; z.y = 0u; *(LAS u32x2*)(sQ + (16 * w + l15) * LP + 16 * (w + 1) + 4 * q) = z; }
            const int nks = (w >> 1) + 1;
            for (int ks = 0; ks < nks; ++ks) {
                const bf16x8 a = *(const LAS bf16x8*)(sQ + (16 * w + l15) * LP + 32 * ks + 8 * q);
#pragma unroll
                for (int nt = 0; nt < 3; ++nt) { const bf16x8 bfr = *(const LAS bf16x8*)(sVt + (16 * nt + l15) * LP + 32 * ks + 8 * q); accO[nt] = __builtin_amdgcn_mfma_f32_16x16x32_bf16(a, bfr, accO[nt], 0, 0, 0); }
            }
#pragma unroll
            for (int i = 0; i < 4; ++i) {
                const int j = 16 * w + 4 * q + i;
                const float den = __shfl(accO[2][i], lane & 48);
                const float dd = fmaxf(fabsf(den), __expf(-(sB[j] + sM[j]))), inv = 1.f / dd;
                float* hp = HF + (size_t)(row0 + (dir ? 127 - j : j)) * DV + h * 256 + sl * 32 + l15;
                hp[0] = accO[0][i] * inv; hp[16] = accO[1][i] * inv;
            }
        }
        {
            const float decay = sS[0];
#pragma unroll
            for (int nt = 0; nt < 3; ++nt) accC[nt] = accC[nt] * decay;
            const int d = 16 * w + l15;
#pragma unroll
            for (int ks = 0; ks < 4; ++ks) {
                const u32x4 kv = *(const LAS u32x4*)(sKt + d * LP + 8 * ((4 * ks + q) ^ ((d >> 3) & 7)));
                const f32x4 w0 = *(const LAS f32x4*)(sW + 32 * ks + 8 * q), w1 = *(const LAS f32x4*)(sW + 32 * ks + 8 * q + 4);
                u32x4 av; av.x = pk2(bflo(kv.x) * w0[0], bfhi(kv.x) * w0[1]); av.y = pk2(bflo(kv.y) * w0[2], bfhi(kv.y) * w0[3]);
                av.z = pk2(bflo(kv.z) * w1[0], bfhi(kv.z) * w1[1]); av.w = pk2(bflo(kv.w) * w1[2], bfhi(kv.w) * w1[3]);
                const bf16x8 a = __builtin_bit_cast(bf16x8, av);
#pragma unroll
                for (int nt = 0; nt < 3; ++nt) { const bf16x8 bfr = *(const LAS bf16x8*)(sVt + (16 * nt + l15) * LP + 32 * ks + 8 * q); accC[nt] = __builtin_amdgcn_mfma_f32_16x16x32_bf16(a, bfr, accC[nt], 0, 0, 0); }
            }
        }
        __syncthreads();
#pragma unroll
        for (int nt = 0; nt < 3; ++nt) { u32x2 wv; wv.x = pk2(accC[nt][0], accC[nt][1]); wv.y = pk2(accC[nt][2], accC[nt][3]); *(LAS u32x2*)(sCt + (16 * nt + l15) * LP + 16 * w + 4 * q) = wv; }
    }
#undef ML_LOAD
    __syncthreads();
}

__device__ __forceinline__ void conv_unit(const Frame& F, int unit, LAS unsigned char* lds) {
    const int tid = threadIdx.x, lane = tid & 63, wv = tid >> 6, c0 = 2 * tid;
    const int b = unit >> 7, r = (unit >> 1) & 63, half = unit & 1;
    const bf16_t* U = F.UB + (size_t)(b * SEQ) * DCONV + c0;
    float y0[32], y1[32];
#pragma unroll
    for (int j = 0; j < 32; ++j) { y0[j] = 0.f; y1[j] = 0.f; }
    if (tid < 256) {
        float w0[31], w1[31];
#pragma unroll
        for (int k = 0; k < 31; ++k) { const f32x2v ww = *(const f32x2v*)(F.conv_w + k * DCONV + c0); w0[k] = ww.x; w1[k] = ww.y; }
#pragma unroll
        for (int i = 0; i < 62; ++i) {
            const int col = half * 32 - 15 + i; float u0 = 0.f, u1 = 0.f;
            if (col >= 0 && col < 64) { const unsigned v = *(const unsigned*)(U + (size_t)(r * 64 + col) * DCONV); u0 = bflo(v); u1 = bfhi(v); }
#pragma unroll
            for (int j = 0; j < 32; ++j) { const int k = i - j; if (k >= 0 && k <= 30) { y0[j] += w0[k] * u0; y1[j] += w1[k] * u1; } }
        }
    } else {
        for (int k = 0; k < 31; ++k) {
            const int rr = r + k - 15; if (rr < 0 || rr >= 64) continue;
            const f32x2v ww = *(const f32x2v*)(F.conv_w + k * DCONV + c0);
            const bf16_t* up = U + (size_t)(rr * 64 + half * 32) * DCONV;
#pragma unroll
            for (int j = 0; j < 32; ++j) { const unsigned v = *(const unsigned*)(up + (size_t)j * DCONV); y0[j] += ww.x * bflo(v); y1[j] += ww.y * bfhi(v); }
        }
    }
    const f32x2v cb = *(const f32x2v*)(F.conv_b + c0);
    LAS float* red = (LAS float*)lds;
    LAS float* stat = red + 512;
#pragma unroll
    for (int j = 0; j < 32; ++j) {
        y0[j] += cb.x; y1[j] += cb.y;
        const float s1 = wsum(y0[j] + y1[j]), s2 = wsum(y0[j] * y0[j] + y1[j] * y1[j]);
        if (lane == 0) { red[wv * 64 + j] = s1; red[wv * 64 + 32 + j] = s2; }
    }
    __syncthreads();
    if (tid < 32) { float a = 0.f, q = 0.f;
#pragma unroll
        for (int g = 0; g < 8; ++g) { a += red[g * 64 + tid]; q += red[g * 64 + 32 + tid]; }
        const float mean = a * (1.f / DCONV), var = fmaxf(q * (1.f / DCONV) - mean * mean, 0.f);
        stat[2 * tid] = mean; stat[2 * tid + 1] = rsqrtf(var + LN_EPS); }
    __syncthreads();
    const f32x2v lg = *(const f32x2v*)(F.conv_g + c0), lb = *(const f32x2v*)(F.conv_bb + c0);
    bf16_t* ap = F.AC + (size_t)(b * SEQ + r * 64 + half * 32) * DCONV + c0;
#pragma unroll
    for (int j = 0; j < 32; ++j) {
        const float mean = stat[2 * j], rstd = stat[2 * j + 1];
        const float a0 = (y0[j] - mean) * rstd * lg.x + lb.x, a1 = (y1[j] - mean) * rstd * lg.y + lb.y;
        *(unsigned*)(ap + (size_t)j * DCONV) = pk2(a0 * sigm(a0), a1 * sigm(a1));
    }
    __syncthreads();
}

struct Args { const float* in[22]; float* out; unsigned char* ws; int ph_lo, ph_hi; };
constexpr int N_PHASES = 14;

__global__ void __launch_bounds__(NTHREADS, 2) hybrid_fwd(Args args) {
    extern __shared__ __attribute__((aligned(16))) unsigned char lds_raw[];
    LAS unsigned char* lds = (LAS unsigned char*)lds_raw;
    cg::grid_group grid = cg::this_grid();
    Frame F;
    F.x = args.in[0]; F.c = args.in[1]; F.ctx = args.in[2]; F.c_ctx = args.in[3]; F.w_ada = args.in[4]; F.b_ada = args.in[5]; F.w_in = args.in[6]; F.b_in = args.in[7];
    F.mh_g = args.in[8]; F.conv_w = args.in[9]; F.conv_b = args.in[10]; F.conv_g = args.in[11]; F.conv_bb = args.in[12]; F.w_m = args.in[13]; F.w_c = args.in[14]; F.w_o = args.in[15];
    F.f1w13 = args.in[16]; F.f1w2 = args.in[17]; F.f2w13 = args.in[18]; F.f2w2 = args.in[19]; F.pg = args.in[20]; F.pb = args.in[21];
    F.out = args.out; unsigned char* ws = args.ws; F.ws = ws;
    F.mod = (float*)(ws + WS_MOD); F.bperm = (float*)(ws + WS_BPERM); F.OBUF = (float*)(ws + WS_OBUF); F.GATES = (float*)(ws + WS_GATES);
    F.W13A = (bf16_t*)(ws + WS_W13A); F.W2A = (bf16_t*)(ws + WS_W2A); F.WIN = (bf16_t*)(ws + WS_WIN); F.WM = (bf16_t*)(ws + WS_WM); F.WC = (bf16_t*)(ws + WS_WC); F.WO = (bf16_t*)(ws + WS_WO);
    F.W13B = (bf16_t*)(ws + WS_W13B); F.W2B = (bf16_t*)(ws + WS_W2B); F.ACTA = (bf16_t*)(ws + WS_ACTA); F.HBUF = (bf16_t*)(ws + WS_HBUF);
    F.KB = (bf16_t*)(ws + WS_KB); F.VB = (bf16_t*)(ws + WS_VB); F.QB = (bf16_t*)(ws + WS_QB); F.OB = (bf16_t*)(ws + WS_OB); F.UB = (bf16_t*)(ws + WS_UB);
    F.GM = (bf16_t*)(ws + WS_GM); F.GC = (bf16_t*)(ws + WS_GC); F.AC = (bf16_t*)(ws + WS_AC);
    float* HF0 = (float*)(ws + WS_HBUF); float* HF1 = (float*)(ws + WS_OBUF); float* TB = (float*)(ws + WS_HBUF); bf16_t* MB = (bf16_t*)(ws + WS_VB);
    const int lo = args.ph_lo, hi = args.ph_hi, G = gridDim.x, bx = blockIdx.x;
#define IN(k) (lo <= (k) && (k) < hi)
#define SEAM(k) do { if (IN(k) && IN((k) + 1)) grid.sync(); } while (0)

    if (IN(0)) { p0_prep(F, lds); } SEAM(0);
    if (IN(1)) { p_modin0(F); } SEAM(1);
    if (IN(2)) {
        pg8::Gemm g{F.ACTA, F.W13A, MT, 2 * DFF, D}; pg8::StaticOrder S; S.init(MT, 2 * DFF, G, bx); EpiSwiGLU E{F.HBUF};
        pg8::gemm_phase<EpiSwiGLU, pg8::StaticOrder, true, true>(lds, g, S, E); } SEAM(2);
    if (IN(3)) {
        pg8::Gemm g{F.HBUF, F.W2A, MT, D, DFF}; pg8::StaticOrder S; S.init(MT, D, G, bx); EpiF32 E{F.OBUF};
        pg8::gemm_phase<EpiF32, pg8::StaticOrder, true, true>(lds, g, S, E); } SEAM(3);
    if (IN(4)) { p_residual<0>(F, 0.5f, MT); } SEAM(4);
    if (IN(5)) {
        pg8::Gemm g{F.ACTA, F.WIN, MT, NINP, D}; InProjOrder S; S.init(G, bx);
        EpiInProj E{F.bperm, F.KB, F.VB, F.QB, F.OB, F.UB, F.GM, F.GC, F.GATES};
        pg8::gemm_phase<EpiInProj, InProjOrder, true, true>(lds, g, S, E); } SEAM(5);
    if (IN(6)) {
        for (int u = bx; u < 256; u += G) mlstm_unit(F, (u & 31) * 8 + (u >> 5), lds, HF0, HF1);
        for (int u = bx; u < 256; u += G) conv_unit(F, u, lds);
    } SEAM(6);
    if (IN(7)) { p_headnorm(F, HF0, HF1); } SEAM(7);
    if (IN(8)) {
        { pg8::Gemm g{F.AC, F.WC, MX, D, DCONV}; pg8::StaticOrder S; S.init(MX, D, G, bx); EpiGateT E{TB, F.GC};
          pg8::gemm_phase<EpiGateT, pg8::StaticOrder, true, true>(lds, g, S, E); }
        { pg8::Gemm g{F.ACTA, F.WM, MX, D, DV}; pg8::StaticOrder S; S.init(MX, D, G, bx); EpiMerge E{TB, F.GM, MB};
          pg8::gemm_phase<EpiMerge, pg8::StaticOrder, true, true>(lds, g, S, E); } } SEAM(8);
    if (IN(9)) {
        pg8::Gemm g{MB, F.WO, MX, D, D}; pg8::StaticOrder S; S.init(MX, D, G, bx); EpiF32 E{F.OBUF};
        pg8::gemm_phase<EpiF32, pg8::StaticOrder, true, true>(lds, g, S, E); } SEAM(9);
    if (IN(10)) { p_residual<1>(F, 1.0f, MX); } SEAM(10);
    if (IN(11)) {
        pg8::Gemm g{F.ACTA, F.W13B, MX, 2 * DFF, D}; pg8::StaticOrder S; S.init(MX, 2 * DFF, G, bx); EpiSwiGLU E{F.HBUF};
        pg8::gemm_phase<EpiSwiGLU, pg8::StaticOrder, true, true>(lds, g, S, E); } SEAM(11);
    if (IN(12)) {
        pg8::Gemm g{F.HBUF, F.W2B, MX, D, DFF}; pg8::StaticOrder S; S.init(MX, D, G, bx); EpiF32 E{F.OBUF};
        pg8::gemm_phase<EpiF32, pg8::StaticOrder, true, true>(lds, g, S, E); } SEAM(12);
    if (IN(13)) { p_residual<2>(F, 0.5f, MX); }
#undef IN
#undef SEAM
}

#ifndef MK_ONE_LAUNCH
#define MK_ONE_LAUNCH 1
#endif
extern "C" void kernel_launch(void* const* d_in, const int* in_sizes, int n_in, void* d_out, int out_size, void* d_ws, size_t ws_size, hipStream_t stream) {
    static int grid = 0;
    if (grid == 0) {
        if (n_in != 22 || out_size != MX * D || ws_size < WS_END) { fprintf(stderr, "kernel_launch: unexpected shapes (n_in %d out %d ws %zu, need %zu)\n", n_in, out_size, ws_size, (size_t)WS_END); grid = -1; return; }
        int dev = 0, cus = 0, per_cu = 0;
        (void)hipGetDevice(&dev); (void)hipDeviceGetAttribute(&cus, hipDeviceAttributeMultiprocessorCount, dev);
        if (hipFuncSetAttribute((const void*)hybrid_fwd, hipFuncAttributeMaxDynamicSharedMemorySize, LDS_BYTES) != hipSuccess) { fprintf(stderr, "kernel_launch: hipFuncSetAttribute failed\n"); grid = -1; return; }
        if (hipOccupancyMaxActiveBlocksPerMultiprocessor(&per_cu, (const void*)hybrid_fwd, NTHREADS, LDS_BYTES) != hipSuccess || per_cu < 1) { fprintf(stderr, "kernel_launch: occupancy query says %d\n", per_cu); (void)hipGetLastError(); per_cu = 1; }
        grid = cus * per_cu; if (grid > 256) grid = 256;
    }
    if (grid < 0) return;
    Args a{};
    for (int i = 0; i < 22; ++i) a.in[i] = (const float*)d_in[i];
    a.out = (float*)d_out; a.ws = (unsigned char*)d_ws;
#if MK_ONE_LAUNCH
    a.ph_lo = 0; a.ph_hi = N_PHASES;
    void* kargs[] = {&a};
    const hipError_t e = hipLaunchCooperativeKernel((const void*)hybrid_fwd, dim3(grid), dim3(NTHREADS), kargs, (size_t)LDS_BYTES, stream);
    if (e != hipSuccess) fprintf(stderr, "kernel_launch: cooperative launch failed: %s (grid %d)\n", hipGetErrorString(e), grid);
#else
    for (int p = 0; p < N_PHASES; ++p) { a.ph_lo = p; a.ph_hi = p + 1; hipLaunchKernelGGL(hybrid_fwd, dim3(grid), dim3(NTHREADS), LDS_BYTES, stream, a); }
#endif
}
```

```cpp
#include <hip/hip_runtime.h>
#include <hip/hip_cooperative_groups.h>
#include <cstdio>
#include <cstdint>
namespace cg = cooperative_groups;
namespace pg8 {
#define PG8_LAS __attribute__((address_space(3)))
typedef unsigned short bf16_t;
typedef short bf16x8 __attribute__((ext_vector_type(8)));
typedef float f32x4 __attribute__((ext_vector_type(4)));
typedef unsigned u32x4 __attribute__((ext_vector_type(4)));
constexpr int BM = 256, BK = 64, HALF = 128, HTB = HALF * BK * 2  , STAGE_BYTES = 8 * HTB, NXCD = 8, WGM = 8;

__host__ __device__ __forceinline__ int lds_byte(int r, int c) { const int st = (r >> 4) * 2 + (c >> 5), rr = r & 15, cc = c & 31, ob = rr * 64 + cc * 2; return st * 1024 + (ob ^ (((ob >> 9) & 1) << 5)); }
__host__ __device__ __forceinline__ void stage_rc(int b, int& R, int& C) { const int st = b / 1024, sb = b % 1024, swz = sb ^ (((sb >> 9) & 1) << 5); R = (st >> 1) * 16 + swz / 64; C = (st & 1) * 32 + (swz % 64) / 2; }
__host__ __device__ __forceinline__ int perm32(int rho) { const int n = rho >> 4, i = rho & 15; return 8 * (i >> 2) + 4 * n + (i & 3); }

struct Unit { int pm, pn, kp; };
struct Gemm { const bf16_t* A; const bf16_t* Bt; int M, N, K, ld; };

struct StaticOrder {
    int nM, nN, nwg, G, c;
    __host__ __device__ void init(int M, int N, int G_, int c_) { nM = M / BM; nN = N / BM; nwg = nM * nN; G = G_; c = c_; }
    __host__ __device__ bool next(int i, Unit& u) const {
        const long L = (long)i * G + c; if (L >= nwg) return false;
        int wgid = (int)L; { const int q = nwg / NXCD, r = nwg % NXCD, xcd = wgid % NXCD, off = wgid / NXCD; wgid = (xcd < r ? xcd * (q + 1) : r * (q + 1) + (xcd - r) * q) + off; }
        const int nig = WGM * nN, gid = wgid / nig, fm = gid * WGM, gsz = (nM - fm) < WGM ? (nM - fm) : WGM;
        u.pm = fm + ((wgid % nig) % gsz); u.pn = (wgid % nig) / gsz; u.kp = 0; return true;
    }
    __device__ __forceinline__ void a_ready(const Unit&) const {}
    __device__ __forceinline__ void done(const Unit&) const {}
};
__device__ __forceinline__ unsigned cvt_pk_bf16(float lo, float hi) { unsigned r; asm volatile("v_cvt_pk_bf16_f32 %0, %1, %2" : "=v"(r) : "v"(lo), "v"(hi)); return r; }
typedef float f32x2 __attribute__((ext_vector_type(2)));
template <class Epi, class Sched, bool ALIGN_EPI = false, bool SP2 = false>
__device__ __forceinline__ void gemm_phase(PG8_LAS unsigned char* lds, const Gemm g, const Sched& S, const Epi& E) {
    const int tid = threadIdx.x, wid = __builtin_amdgcn_readfirstlane(tid >> 6), lane = tid & 63, wr = wid >> 2, wc = wid & 3, fr = lane & 15, fq = lane >> 4;
    const int K = g.K, nt = K / BK;
    unsigned voffA[2], voffB[2];
#pragma unroll
    for (int i = 0; i < 2; ++i) { int R, C; stage_rc(tid * 16 + i * 8192, R, C); const int Rb = Epi::PERM ? ((R & ~31) + perm32(R & 31)) : R;
        voffA[i] = (unsigned)(R * g.ld + C) * 2u; voffB[i] = (unsigned)(Rb * g.ld + C) * 2u; }
    const size_t kstep = (size_t)(BK * 2);
    const size_t hstep = (size_t)HALF * g.ld * 2;
    const size_t tstep = 2 * hstep;
    const unsigned ldsw = (unsigned)wid * 1024u;
    const int aoff = lds_byte(wr * 64 + fr, fq * 8), boff = lds_byte(wc * 32 + fr, fq * 8);
#define PG8_SA(b, h) (((b) * 2 + (h)) * HTB)
#define PG8_SB(b, h) ((4 + (b) * 2 + (h)) * HTB)
#define PG8_STAGE(bufoff, gbase, voff) do { _Pragma("unroll") for (int _i = 0; _i < 2; ++_i) \
        __builtin_amdgcn_global_load_lds((const unsigned*)((const char*)(gbase) + (voff)[_i]), (PG8_LAS unsigned*)(lds + (bufoff) + ldsw + _i * 8192), 16, 0, 0); } while (0)
#define PG8_LDA(dst, b, h) do { _Pragma("unroll") for (int m = 0; m < 4; ++m) _Pragma("unroll") for (int k = 0; k < 2; ++k) dst[m][k] = *(const PG8_LAS bf16x8*)(lds + PG8_SA(b, h) + aoff + m * 2048 + k * 1024); } while (0)
#define PG8_LDB(dst, b, h) do { _Pragma("unroll") for (int n = 0; n < 2; ++n) _Pragma("unroll") for (int k = 0; k < 2; ++k) dst[n][k] = *(const PG8_LAS bf16x8*)(lds + PG8_SB(b, h) + boff + n * 2048 + k * 1024); } while (0)
#define PG8_MMA(ai, bj, At, Bt) do { __builtin_amdgcn_s_setprio(1); _Pragma("unroll") for (int m = 0; m < 4; ++m) _Pragma("unroll") for (int n = 0; n < 2; ++n) _Pragma("unroll") for (int k = 0; k < 2; ++k) \
        acc[ai][bj][m][n] = __builtin_amdgcn_mfma_f32_16x16x32_bf16(Bt[n][k], At[m][k], acc[ai][bj][m][n], 0, 0, 0); __builtin_amdgcn_s_setprio(0); } while (0)
#define PG8_WAIT_V(n) asm volatile("s_waitcnt vmcnt(" #n ")" ::: "memory")
#define PG8_WAIT_L(n) asm volatile("s_waitcnt lgkmcnt(" #n ")" ::: "memory")
#define PG8_BAR __builtin_amdgcn_s_barrier()
#define PG8_SCHED __builtin_amdgcn_sched_barrier(0)
    Unit cur, nxt; int ui = 0;
    if (!S.next(0, cur)) return;
    f32x4 acc[2][2][4][2];
#pragma unroll
    for (int a = 0; a < 2; ++a)
#pragma unroll
        for (int b = 0; b < 2; ++b)
#pragma unroll
            for (int m = 0; m < 4; ++m)
#pragma unroll
                for (int n = 0; n < 2; ++n) acc[a][b][m][n] = (f32x4){0.f, 0.f, 0.f, 0.f};
    bf16x8 At[4][2], B0[2][2], B1[2][2];
    const char* cA = (const char*)g.A + (size_t)cur.pm * tstep + (size_t)cur.kp * K * 2; const char* cB = (const char*)g.Bt + (size_t)cur.pn * tstep + (size_t)cur.kp * K * 2;
    S.a_ready(cur);
    if constexpr (SP2) {
        PG8_STAGE(PG8_SB(0, 0), cB, voffB); PG8_STAGE(PG8_SB(0, 1), cB + hstep, voffB); PG8_STAGE(PG8_SA(0, 0), cA, voffA); PG8_STAGE(PG8_SA(0, 1), cA + hstep, voffA);
        if (wr == 1) PG8_BAR;
        PG8_WAIT_V(2); PG8_BAR;
        PG8_STAGE(PG8_SB(1, 0), cB + kstep, voffB); PG8_STAGE(PG8_SA(1, 0), cA + kstep, voffA); PG8_STAGE(PG8_SB(1, 1), cB + hstep + kstep, voffB);
        PG8_WAIT_V(6); PG8_BAR;
    } else {
        PG8_STAGE(PG8_SB(0, 0), cB, voffB); PG8_STAGE(PG8_SA(0, 0), cA, voffA); PG8_STAGE(PG8_SB(0, 1), cB + hstep, voffB); PG8_STAGE(PG8_SA(0, 1), cA + hstep, voffA);
        if (wr == 1) PG8_BAR;
        PG8_WAIT_V(4); PG8_BAR;
        PG8_STAGE(PG8_SB(1, 0), cB + kstep, voffB); PG8_STAGE(PG8_SA(1, 0), cA + kstep, voffA); PG8_STAGE(PG8_SB(1, 1), cB + hstep + kstep, voffB);
        PG8_WAIT_V(6); PG8_BAR;
    }
    for (;;) {
        const bool has_next = S.next(ui + 1, nxt);
        const char* nA = has_next ? (const char*)g.A + (size_t)nxt.pm * tstep + (size_t)nxt.kp * K * 2 : cA; const char* nB = has_next ? (const char*)g.Bt + (size_t)nxt.pn * tstep + (size_t)nxt.kp * K * 2 : cB;
        for (int t = 0; t < nt; t += 2) {
            const bool last = (t == nt - 2);
            const char* a1 = cA + (size_t)(t + 1) * kstep;
            const char* a2 = last ? nA : cA + (size_t)(t + 2) * kstep; const char* b2 = last ? nB : cB + (size_t)(t + 2) * kstep;
            const char* a3 = a2 + kstep; const char* b3 = b2 + kstep;
            if (last && has_next) S.a_ready(nxt);
            if constexpr (SP2) {
            PG8_LDB(B0, 0, 0); PG8_LDB(B1, 0, 1); PG8_SCHED; PG8_LDA(At, 0, 0); PG8_STAGE(PG8_SA(1, 1), a1 + hstep, voffA);
            PG8_WAIT_V(8); PG8_WAIT_L(0); PG8_BAR; PG8_MMA(0, 0, At, B0); PG8_MMA(0, 1, At, B1); PG8_BAR; PG8_SCHED;
            PG8_LDA(At, 0, 1); PG8_STAGE(PG8_SB(0, 0), b2, voffB); PG8_STAGE(PG8_SB(0, 1), b2 + hstep, voffB); PG8_STAGE(PG8_SA(0, 0), a2, voffA);
            PG8_WAIT_V(8); PG8_WAIT_L(0); PG8_BAR; PG8_MMA(1, 0, At, B0); PG8_MMA(1, 1, At, B1); PG8_BAR; PG8_SCHED;
            PG8_LDB(B0, 1, 0); PG8_LDB(B1, 1, 1); PG8_SCHED; PG8_LDA(At, 1, 0); PG8_STAGE(PG8_SA(0, 1), a2 + hstep, voffA);
            PG8_WAIT_V(8); PG8_WAIT_L(0); PG8_BAR; PG8_MMA(0, 0, At, B0); PG8_MMA(0, 1, At, B1); PG8_BAR; PG8_SCHED;
            PG8_LDA(At, 1, 1); PG8_STAGE(PG8_SB(1, 0), b3, voffB); PG8_STAGE(PG8_SB(1, 1), b3 + hstep, voffB); PG8_STAGE(PG8_SA(1, 0), a3, voffA);
            PG8_WAIT_V(8); PG8_WAIT_L(0); PG8_BAR; PG8_MMA(1, 0, At, B0); PG8_MMA(1, 1, At, B1); PG8_BAR; PG8_SCHED;
            } else {
            PG8_LDB(B0, 0, 0); PG8_SCHED; PG8_LDA(At, 0, 0); PG8_STAGE(PG8_SA(1, 1), a1 + hstep, voffA);
            PG8_WAIT_L(8); PG8_BAR; PG8_WAIT_L(0); PG8_MMA(0, 0, At, B0); PG8_BAR; PG8_SCHED;
            PG8_LDB(B1, 0, 1); PG8_STAGE(PG8_SB(0, 0), b2, voffB);
            PG8_BAR; PG8_WAIT_L(0); PG8_MMA(0, 1, At, B1); PG8_BAR;
            PG8_LDA(At, 0, 1); PG8_STAGE(PG8_SA(0, 0), a2, voffA);
            PG8_BAR; PG8_WAIT_L(0); PG8_MMA(1, 0, At, B0); PG8_BAR; PG8_SCHED;
            PG8_STAGE(PG8_SB(0, 1), b2 + hstep, voffB);
            PG8_WAIT_V(6); PG8_BAR; PG8_MMA(1, 1, At, B1); PG8_BAR;
            PG8_LDB(B0, 1, 0); PG8_SCHED; PG8_LDA(At, 1, 0); PG8_STAGE(PG8_SA(0, 1), a2 + hstep, voffA);
            PG8_WAIT_L(8); PG8_BAR; PG8_WAIT_L(0); PG8_MMA(0, 0, At, B0); PG8_BAR; PG8_SCHED;
            PG8_LDB(B1, 1, 1); PG8_STAGE(PG8_SB(1, 0), b3, voffB);
            PG8_BAR; PG8_WAIT_L(0); PG8_MMA(0, 1, At, B1); PG8_BAR;
            PG8_LDA(At, 1, 1); PG8_STAGE(PG8_SA(1, 0), a3, voffA);
            PG8_BAR; PG8_WAIT_L(0); PG8_MMA(1, 0, At, B0); PG8_BAR; PG8_SCHED;
            PG8_STAGE(PG8_SB(1, 1), b3 + hstep, voffB);
            PG8_WAIT_V(6); PG8_BAR; PG8_MMA(1, 1, At, B1); PG8_BAR;
            }
        }
        if constexpr (ALIGN_EPI) { if (wr == 0) PG8_BAR; }
        if constexpr (!Epi::AFTER_DRAIN) { E(acc, cur, wr, wc, fr, fq); S.done(cur); }
        if (!has_next) break;
#pragma unroll
        for (int a = 0; a < 2; ++a)
#pragma unroll
            for (int b = 0; b < 2; ++b)
#pragma unroll
                for (int m = 0; m < 4; ++m)
#pragma unroll
                    for (int n = 0; n < 2; ++n) acc[a][b][m][n] = (f32x4){0.f, 0.f, 0.f, 0.f};
        cur = nxt; cA = nA; cB = nB; ++ui;
        if constexpr (ALIGN_EPI) { if (wr == 1) PG8_BAR; }
    }
    PG8_WAIT_V(0);
    if constexpr (!ALIGN_EPI) { if (wr == 0) PG8_BAR; }
    PG8_BAR;
    if constexpr (Epi::AFTER_DRAIN) { E.fused(acc, cur, wr, wc, fr, fq, lds, wid, lane); S.done(cur); }
#undef PG8_SA
#undef PG8_SB
#undef PG8_STAGE
#undef PG8_LDA
#undef PG8_LDB
#undef PG8_MMA
#undef PG8_WAIT_V
#undef PG8_WAIT_L
#undef PG8_BAR
#undef PG8_SCHED
}
}

using pg8::f32x4; using pg8::bf16x8; using pg8::u32x4; using pg8::bf16_t;
#define LAS __attribute__((address_space(3)))
typedef unsigned u32x2 __attribute__((ext_vector_type(2)));
typedef float f32x2v __attribute__((ext_vector_type(2)));

constexpr int D = 2048, SEQ = 4096, MX = 8192, MC = 512, MT = 8704, CTXL = 256;
constexpr int NH = 8, DQK = 1024, DV = 2048, DCONV = 1024, DFF = 5632;
constexpr int NINP = 12544;
constexpr float LN_EPS = 1e-5f, ALPHA = 1.189207115002721f  , QSCALE = 0.08838834764831845f;
constexpr int NWAVES = 8, NTHREADS = 512;

constexpr size_t MiB = 1u << 20;
constexpr size_t WS_MOD = 4096, WS_BAR = 256 * 1024, WS_BPERM = 512 * 1024;
constexpr size_t WS_W13A = 1 * MiB, WS_W2A = 45 * MiB, WS_WIN = 67 * MiB, WS_WM = 116 * MiB, WS_WC = 124 * MiB, WS_WO = 128 * MiB, WS_W13B = 136 * MiB, WS_W2B = 180 * MiB;
constexpr size_t WS_ACTA = 202 * MiB, WS_HBUF = 236 * MiB, WS_OBUF = 330 * MiB;
constexpr size_t WS_KB = 402 * MiB, WS_VB = 419 * MiB, WS_QB = 453 * MiB, WS_OB = 469 * MiB, WS_UB = 501 * MiB, WS_GM = 517 * MiB, WS_GC = 549 * MiB, WS_GATES = 581 * MiB, WS_AC = 583 * MiB;
constexpr size_t WS_END = 599 * MiB;

constexpr int LDS_BYTES = 135168;

__device__ __forceinline__ float bf2f(unsigned b) { return __uint_as_float(b << 16); }
__device__ __forceinline__ float bflo(unsigned w) { return __uint_as_float(w << 16); }
__device__ __forceinline__ float bfhi(unsigned w) { return __uint_as_float(w & 0xffff0000u); }
__device__ __forceinline__ unsigned pk2(float lo, float hi) { return pg8::cvt_pk_bf16(lo, hi); }
__device__ __forceinline__ float sigm(float x) { return __builtin_amdgcn_rcpf(1.f + __expf(-x)); }
__device__ __forceinline__ float wsum(float v) {
#pragma unroll
    for (int o = 32; o >= 1; o >>= 1) v += __shfl_xor(v, o);
    return v;
}

struct Frame {
    const float *x, *c, *ctx, *c_ctx, *w_ada, *b_ada, *w_in, *b_in, *mh_g, *conv_w, *conv_b, *conv_g, *conv_bb, *w_m, *w_c, *w_o, *f1w13, *f1w2, *f2w13, *f2w2, *pg, *pb;
    float* out; unsigned char* ws;
    float *mod, *bperm, *OBUF, *GATES;
    bf16_t *W13A, *W2A, *WIN, *WM, *WC, *WO, *W13B, *W2B, *ACTA, *HBUF, *KB, *VB, *QB, *OB, *UB, *GM, *GC, *AC;
};

struct EpiSwiGLU {
    static constexpr bool PERM = true, AFTER_DRAIN = false;
    bf16_t* H;
    __device__ __forceinline__ void operator()(const f32x4 (&acc)[2][2][4][2], const pg8::Unit& u, int wr, int wc, int fr, int fq) const {
        const int row0 = u.pm * 256 + wr * 64 + fr, col0 = u.pn * 128 + wc * 32 + 8 * fq;
#pragma unroll
        for (int ai = 0; ai < 2; ++ai)
#pragma unroll
            for (int m = 0; m < 4; ++m) {
                bf16_t* p = H + (size_t)(row0 + ai * 128 + m * 16) * DFF + col0;
                float h[8];
#pragma unroll
                for (int n = 0; n < 2; ++n)
#pragma unroll
                    for (int j = 0; j < 4; ++j) { const float a = acc[ai][0][m][n][j], g = acc[ai][1][m][n][j]; h[n * 4 + j] = a * sigm(a) * g; }
                u32x4 w; w.x = pk2(h[0], h[1]); w.y = pk2(h[2], h[3]); w.z = pk2(h[4], h[5]); w.w = pk2(h[6], h[7]);
                *(u32x4*)p = w;
            }
    }
};
struct EpiF32 {
    static constexpr bool PERM = false, AFTER_DRAIN = false;
    float* C;
    __device__ __forceinline__ void operator()(const f32x4 (&acc)[2][2][4][2], const pg8::Unit& u, int wr, int wc, int fr, int fq) const {
        const int row0 = u.pm * 256 + wr * 64 + fr, col0 = u.pn * 256 + wc * 32 + 4 * fq;
#pragma unroll
        for (int ai = 0; ai < 2; ++ai)
#pragma unroll
            for (int m = 0; m < 4; ++m) { float* rowp = C + (size_t)(row0 + ai * 128 + m * 16) * D + col0;
#pragma unroll
                for (int bj = 0; bj < 2; ++bj)
#pragma unroll
                    for (int n = 0; n < 2; ++n) *(f32x4*)(rowp + bj * 128 + n * 16) = acc[ai][bj][m][n]; }
    }
};
struct EpiGateT {
    static constexpr bool PERM = false, AFTER_DRAIN = false;
    float* T; const bf16_t* G;
    __device__ __forceinline__ void operator()(const f32x4 (&acc)[2][2][4][2], const pg8::Unit& u, int wr, int wc, int fr, int fq) const {
        const int row0 = u.pm * 256 + wr * 64 + fr, col0 = u.pn * 256 + wc * 32 + 4 * fq;
#pragma unroll
        for (int ai = 0; ai < 2; ++ai)
#pragma unroll
            for (int m = 0; m < 4; ++m) { const size_t ro = (size_t)(row0 + ai * 128 + m * 16) * D + col0;
#pragma unroll
                for (int bj = 0; bj < 2; ++bj)
#pragma unroll
                    for (int n = 0; n < 2; ++n) { const size_t o = ro + bj * 128 + n * 16; const u32x2 gv = *(const u32x2*)(G + o); const f32x4 a = acc[ai][bj][m][n];
                        f32x4 r; r[0] = a[0] * bflo(gv.x); r[1] = a[1] * bfhi(gv.x); r[2] = a[2] * bflo(gv.y); r[3] = a[3] * bfhi(gv.y); *(f32x4*)(T + o) = r; } }
    }
};
struct EpiMerge {
    static constexpr bool PERM = false, AFTER_DRAIN = false;
    const float* T; const bf16_t* G; bf16_t* O;
    __device__ __forceinline__ void operator()(const f32x4 (&acc)[2][2][4][2], const pg8::Unit& u, int wr, int wc, int fr, int fq) const {
        const int row0 = u.pm * 256 + wr * 64 + fr, col0 = u.pn * 256 + wc * 32 + 4 * fq;
#pragma unroll
        for (int ai = 0; ai < 2; ++ai)
#pragma unroll
            for (int m = 0; m < 4; ++m) { const size_t ro = (size_t)(row0 + ai * 128 + m * 16) * D + col0;
#pragma unroll
                for (int bj = 0; bj < 2; ++bj)
#pragma unroll
                    for (int n = 0; n < 2; ++n) { const size_t o = ro + bj * 128 + n * 16; const u32x2 gv = *(const u32x2*)(G + o); const f32x4 t = *(const f32x4*)(T + o); const f32x4 a = acc[ai][bj][m][n];
                        u32x2 w; w.x = pk2(a[0] * bflo(gv.x) + t[0], a[1] * bfhi(gv.x) + t[1]); w.y = pk2(a[2] * bflo(gv.y) + t[2], a[3] * bfhi(gv.y) + t[3]); *(u32x2*)(O + o) = w; } }
    }
};
struct EpiInProj {
    static constexpr bool PERM = true, AFTER_DRAIN = false;
    const float* bias; bf16_t *KB, *VB, *QB, *OB, *UB, *GM, *GC; float* GATES;
    __device__ __forceinline__ void operator()(const f32x4 (&acc)[2][2][4][2], const pg8::Unit& u, int wr, int wc, int fr, int fq) const {
        const int pn = u.pn, row0 = u.pm * 256 + wr * 64 + fr, lc0 = wc * 32 + 8 * fq;
        if (pn == 48) {
            if (wc == 0) {
                const f32x4 b0 = *(const f32x4*)(bias + 12288 + 8 * fq), b1 = *(const f32x4*)(bias + 12288 + 8 * fq + 4);
#pragma unroll
                for (int ai = 0; ai < 2; ++ai)
#pragma unroll
                    for (int m = 0; m < 4; ++m) { float* p = GATES + (size_t)(row0 + ai * 128 + m * 16) * 32 + 8 * fq;
                        *(f32x4*)p = acc[ai][0][m][0] + b0; *(f32x4*)(p + 4) = acc[ai][0][m][1] + b1; }
            }
            return;
        }
        if (pn >= 24 && pn < 32) {
            const int col = (pn - 24) * 128 + lc0;
            const f32x4 ba0 = *(const f32x4*)(bias + pn * 256 + lc0), ba1 = *(const f32x4*)(bias + pn * 256 + lc0 + 4);
            const f32x4 bg0 = *(const f32x4*)(bias + pn * 256 + 128 + lc0), bg1 = *(const f32x4*)(bias + pn * 256 + 128 + lc0 + 4);
#pragma unroll
            for (int ai = 0; ai < 2; ++ai)
#pragma unroll
                for (int m = 0; m < 4; ++m) {
                    const f32x4 a0 = acc[ai][0][m][0] + ba0, a1 = acc[ai][0][m][1] + ba1, g0 = acc[ai][1][m][0] + bg0, g1 = acc[ai][1][m][1] + bg1;
                    u32x4 w; w.x = pk2(a0[0] * sigm(g0[0]), a0[1] * sigm(g0[1])); w.y = pk2(a0[2] * sigm(g0[2]), a0[3] * sigm(g0[3]));
                    w.z = pk2(a1[0] * sigm(g1[0]), a1[1] * sigm(g1[1])); w.w = pk2(a1[2] * sigm(g1[2]), a1[3] * sigm(g1[3]));
                    *(u32x4*)(UB + (size_t)(row0 + ai * 128 + m * 16) * DCONV + col) = w;
                }
            return;
        }
        bf16_t* dst; int ldc, cb, mode;
        if (pn < 4) { dst = KB; ldc = DQK; cb = pn * 256; mode = 0; }
        else if (pn < 12) { dst = VB; ldc = DV; cb = (pn - 4) * 256; mode = 0; }
        else if (pn < 16) { dst = QB; ldc = DQK; cb = (pn - 12) * 256; mode = 1; }
        else if (pn < 24) { dst = OB; ldc = DV; cb = (pn - 16) * 256; mode = 2; }
        else if (pn < 40) { dst = GM; ldc = D; cb = (pn - 32) * 256; mode = 2; }
        else { dst = GC; ldc = D; cb = (pn - 40) * 256; mode = 2; }
#pragma unroll
        for (int bj = 0; bj < 2; ++bj) {
            const f32x4 b0 = *(const f32x4*)(bias + pn * 256 + bj * 128 + lc0), b1 = *(const f32x4*)(bias + pn * 256 + bj * 128 + lc0 + 4);
#pragma unroll
            for (int ai = 0; ai < 2; ++ai)
#pragma unroll
                for (int m = 0; m < 4; ++m) {
                    f32x4 v0 = acc[ai][bj][m][0] + b0, v1 = acc[ai][bj][m][1] + b1;
                    if (mode == 1) { v0 = v0 * QSCALE; v1 = v1 * QSCALE; }
                    if (mode == 2) {
#pragma unroll
                        for (int j = 0; j < 4; ++j) { v0[j] = sigm(v0[j]); v1[j] = sigm(v1[j]); } }
                    u32x4 w; w.x = pk2(v0[0], v0[1]); w.y = pk2(v0[2], v0[3]); w.z = pk2(v1[0], v1[1]); w.w = pk2(v1[2], v1[3]);
                    *(u32x4*)(dst + (size_t)(row0 + ai * 128 + m * 16) * ldc + cb + bj * 128 + lc0) = w;
                }
        }
    }
};
struct InProjOrder {
    pg8::StaticOrder so;
    __device__ void init(int G, int c) { so.init(MX, NINP, G, c); }
    __device__ bool next(int i, pg8::Unit& u) const {
        if (so.next(i, u)) return true;
        const long L = (long)i * so.G + so.c - so.nwg; if (L >= 26) return false;
        const int j = (int)L % 13; u.pm = 32 + (int)L / 13; u.pn = j < 12 ? j : 48; u.kp = 0; return true;
    }
    __device__ __forceinline__ void a_ready(const pg8::Unit&) const {}
    __device__ __forceinline__ void done(const pg8::Unit&) const {}
};

constexpr int CTX_KSPLIT = 11;
struct CtxSplitOrder {
    int G, c;
    __device__ bool next(int i, pg8::Unit& u) const {
        const long L = (long)i * G + c; if (L >= 16 * CTX_KSPLIT) return false;
        const int t = (int)L / CTX_KSPLIT; u.kp = (int)L % CTX_KSPLIT; u.pm = 32 + (t >> 3); u.pn = t & 7; return true;
    }
    __device__ __forceinline__ void a_ready(const pg8::Unit&) const {}
    __device__ __forceinline__ void done(const pg8::Unit&) const {}
};
struct EpiPart {
    static constexpr bool PERM = false, AFTER_DRAIN = false;
    float* P;
    __device__ __forceinline__ void operator()(const f32x4 (&acc)[2][2][4][2], const pg8::Unit& u, int wr, int wc, int fr, int fq) const {
        const int row0 = (u.pm - 32) * 256 + wr * 64 + fr, col0 = u.pn * 256 + wc * 32 + 4 * fq;
        float* base = P + (size_t)u.kp * MC * D;
#pragma unroll
        for (int ai = 0; ai < 2; ++ai)
#pragma unroll
            for (int m = 0; m < 4; ++m) { float* rowp = base + (size_t)(row0 + ai * 128 + m * 16) * D + col0;
#pragma unroll
                for (int bj = 0; bj < 2; ++bj)
#pragma unroll
                    for (int n = 0; n < 2; ++n) *(f32x4*)(rowp + bj * 128 + n * 16) = acc[ai][bj][m][n]; }
    }
};

__device__ __forceinline__ int map_col(int mode, int n) {
    if (mode == 0) return n;
    if (mode == 1) { const int t = n >> 8, i = n & 255; return i < 128 ? 128 * t + i : DFF + 128 * t + (i - 128); }
    if (n < 3072) return n;
    if (n < 4096) return 3104 + (n - 3072);
    if (n < 6144) return 4128 + (n - 4096);
    if (n < 8192) { const int t = (n - 6144) >> 8, i = (n - 6144) & 255; return i < 128 ? 6176 + 128 * t + i : 6176 + 1024 + 128 * t + (i - 128); }
    if (n < 12288) return 8224 + (n - 8192);
    if (n < 12320) return 3072 + (n - 12288);
    return -1;
}
__device__ __forceinline__ void adaln_group(const Frame& F, int grp, LAS unsigned char* lds) {
    LAS float* sc = (LAS float*)lds;
    LAS float* red = (LAS float*)(lds + 3 * 2048 * 4);
    const int tid = threadIdx.x;
    for (int i = tid; i < 3 * 2048; i += NTHREADS) { const int r = i >> 11, k = i & 2047; const float v = r < 2 ? F.c[r * 2048 + k] : F.c_ctx[k]; sc[i] = v * (1.f / (1.f + expf(-v))); }
    __syncthreads();
    const int c4 = tid % 18, kg = tid / 18, n0 = grp * 72 + c4 * 4;
    f32x4 a0 = {0.f, 0.f, 0.f, 0.f}, a1 = a0, a2 = a0;
    if (kg < 28) {
        const float* wp = F.w_ada + n0;
        int k = kg;
        for (; k + 28 * 7 < 2048; k += 28 * 8) {
            f32x4 wv[8];
#pragma unroll
            for (int u = 0; u < 8; ++u) wv[u] = __builtin_nontemporal_load((const f32x4*)(wp + (size_t)(k + 28 * u) * (9 * D)));
#pragma unroll
            for (int u = 0; u < 8; ++u) { const int kk = k + 28 * u; a0 += wv[u] * sc[kk]; a1 += wv[u] * sc[2048 + kk]; a2 += wv[u] * sc[4096 + kk]; }
        }
        for (; k < 2048; k += 28) { const f32x4 w = __builtin_nontemporal_load((const f32x4*)(wp + (size_t)k * (9 * D))); a0 += w * sc[k]; a1 += w * sc[2048 + k]; a2 += w * sc[4096 + k]; }
        LAS float* p = red + (kg * 18 + c4) * 12;
        *(LAS f32x4*)p = a0; *(LAS f32x4*)(p + 4) = a1; *(LAS f32x4*)(p + 8) = a2;
    }
    __syncthreads();
    if (tid < 216) {
        const int cc = tid / 12, e = tid % 12, r = e >> 2, j = e & 3; float s = 0.f;
        for (int g = 0; g < 28; ++g) s += red[(g * 18 + cc) * 12 + e];
        const int n = grp * 72 + cc * 4 + j;
        F.mod[r * (9 * D) + n] = s + F.b_ada[n];
    }
    __syncthreads();
}
__device__ __forceinline__ void cvt_tile(const float* W, int Nsrc, bf16_t* Bt, int K, int k0, int n0, int mode) {
    const int tid = threadIdx.x, n4 = tid & 63, kgrp = tid >> 6;
    const int n = n0 + 4 * n4, src = map_col(mode, n), kb = k0 + 8 * kgrp;
    f32x4 v[8];
    if (src >= 0) {
#pragma unroll
        for (int i = 0; i < 8; ++i) v[i] = __builtin_nontemporal_load((const f32x4*)(W + (size_t)(kb + i) * Nsrc + src));
    } else {
#pragma unroll
        for (int i = 0; i < 8; ++i) v[i] = (f32x4){0.f, 0.f, 0.f, 0.f};
    }
#pragma unroll
    for (int c = 0; c < 4; ++c) { u32x4 w; w.x = pk2(v[0][c], v[1][c]); w.y = pk2(v[2][c], v[3][c]); w.z = pk2(v[4][c], v[5][c]); w.w = pk2(v[6][c], v[7][c]);
        *(u32x4*)(Bt + (size_t)(n + c) * K + kb) = w; }
}
__device__ __forceinline__ void p0_prep(const Frame& F, LAS unsigned char* lds) {
    for (int g = blockIdx.x; g < 256; g += gridDim.x) adaln_group(F, g, lds);
    for (int i = blockIdx.x * NTHREADS + threadIdx.x; i < NINP; i += gridDim.x * NTHREADS) { const int s = map_col(2, i); F.bperm[i] = s >= 0 ? F.b_in[s] : 0.f; }
    constexpr int T0 = 1408, T1 = 704, T2 = 1568, T3 = 256, T4 = 128, T5 = 256, T6 = 1408, T7 = 704, TT = T0 + T1 + T2 + T3 + T4 + T5 + T6 + T7;
    for (int T = blockIdx.x; T < TT; T += gridDim.x) {
        int t = T; const float* W; bf16_t* Bt; int Nsrc, K, Np, mode;
        if (t < T0) { W = F.f1w13; Bt = F.W13A; Nsrc = 2 * DFF; K = D; Np = 2 * DFF; mode = 1; }
        else if ((t -= T0) < T1) { W = F.f1w2; Bt = F.W2A; Nsrc = D; K = DFF; Np = D; mode = 0; }
        else if ((t -= T1) < T2) { W = F.w_in; Bt = F.WIN; Nsrc = 12320; K = D; Np = NINP; mode = 2; }
        else if ((t -= T2) < T3) { W = F.w_m; Bt = F.WM; Nsrc = D; K = DV; Np = D; mode = 0; }
        else if ((t -= T3) < T4) { W = F.w_c; Bt = F.WC; Nsrc = D; K = DCONV; Np = D; mode = 0; }
        else if ((t -= T4) < T5) { W = F.w_o; Bt = F.WO; Nsrc = D; K = D; Np = D; mode = 0; }
        else if ((t -= T5) < T6) { W = F.f2w13; Bt = F.W13B; Nsrc = 2 * DFF; K = D; Np = 2 * DFF; mode = 1; }
        else { t -= T6; W = F.f2w2; Bt = F.W2B; Nsrc = D; K = DFF; Np = D; mode = 0; }
        const int ntn = Np / 256, tn = t % ntn, tk = t / ntn;
        cvt_tile(W, Nsrc, Bt, K, tk * 64, tn * 256, mode);
    }
}

__device__ __forceinline__ void store_modin(const f32x4 (&y)[8], const float* modr, int sub, bf16_t* arow, int lane) {
    const float* shift = modr + (sub * 3 + 0) * D; const float* scale = modr + (sub * 3 + 1) * D;
#pragma unroll
    for (int i = 0; i < 8; ++i) { const int idx = (i * 64 + lane) * 4; const f32x4 s = *(const f32x4*)(scale + idx), sh = *(const f32x4*)(shift + idx);
        const f32x4 o = y[i] * (s + 1.f) + sh; u32x2 w; w.x = pk2(o[0], o[1]); w.y = pk2(o[2], o[3]); *(u32x2*)(arow + idx) = w; }
}
__device__ __forceinline__ void p_modin0(const Frame& F) {
    const int lane = threadIdx.x & 63, wv = threadIdx.x >> 6;
    for (int row = blockIdx.x * NWAVES + wv; row < MT; row += gridDim.x * NWAVES) {
        const float* src = row < MX ? F.x + (size_t)row * D : F.ctx + (size_t)(row - MX) * D;
        const int r = row < MX ? row >> 12 : 2;
        f32x4 y[8];
#pragma unroll
        for (int i = 0; i < 8; ++i) y[i] = *(const f32x4*)(src + (i * 64 + lane) * 4);
        store_modin(y, F.mod + r * 9 * D, 0, F.ACTA + (size_t)row * D, lane);
    }
}
template <int SUB> __device__ __forceinline__ void p_residual(const Frame& F, float weight, int nrows, const float* PART) {
    const int lane = threadIdx.x & 63, wv = threadIdx.x >> 6;
    for (int row = blockIdx.x * NWAVES + wv; row < nrows; row += gridDim.x * NWAVES) {
        const bool isx = row < MX;
        const float* xin = isx ? ((SUB == 0 ? F.x : (const float*)F.out) + (size_t)row * D) : F.ctx + (size_t)(row - MX) * D;
        const int r = isx ? row >> 12 : 2;
        const float* modr = F.mod + r * 9 * D; const float* gate = modr + (SUB * 3 + 2) * D;
        const float* orow = F.OBUF + (size_t)row * D; const float* lg = F.pg + SUB * D; const float* lb = F.pb + SUB * D;
        f32x4 v[8]; float s = 0.f;
#pragma unroll
        for (int i = 0; i < 8; ++i) { const int idx = (i * 64 + lane) * 4; const f32x4 xv = *(const f32x4*)(xin + idx), gv = *(const f32x4*)(gate + idx); f32x4 ov;
            if (isx) ov = *(const f32x4*)(orow + idx);
            else { ov = (f32x4){0.f, 0.f, 0.f, 0.f};
#pragma unroll
                for (int p = 0; p < CTX_KSPLIT; ++p) ov += *(const f32x4*)(PART + ((size_t)p * MC + (row - MX)) * D + idx); }
            v[i] = xv * ALPHA + (gv * weight) * ov; s += (v[i][0] + v[i][1]) + (v[i][2] + v[i][3]); }
        const float mean = wsum(s) * (1.f / D); float q = 0.f;
#pragma unroll
        for (int i = 0; i < 8; ++i) { v[i] = v[i] - mean; q += (v[i][0] * v[i][0] + v[i][1] * v[i][1]) + (v[i][2] * v[i][2] + v[i][3] * v[i][3]); }
        const float rstd = rsqrtf(wsum(q) * (1.f / D) + LN_EPS);
#pragma unroll
        for (int i = 0; i < 8; ++i) { const int idx = (i * 64 + lane) * 4; v[i] = v[i] * rstd * *(const f32x4*)(lg + idx) + *(const f32x4*)(lb + idx);
            if (isx) *(f32x4*)(F.out + (size_t)row * D + idx) = v[i]; }
        if (SUB < 2) store_modin(v, modr, SUB + 1, F.ACTA + (size_t)row * D, lane);
    }
}
__device__ __forceinline__ void p_headnorm(const Frame& F, const float* HF0, const float* HF1) {
    const int lane = threadIdx.x & 63, wv = threadIdx.x >> 6;
    for (int row = blockIdx.x * NWAVES + wv; row < MX; row += gridDim.x * NWAVES) {
#pragma unroll
        for (int hh = 0; hh < NH; ++hh) {
            const size_t o = (size_t)row * DV + hh * 256 + lane * 4;
            f32x4 v = *(const f32x4*)(HF0 + o) + *(const f32x4*)(HF1 + o);
            const float mean = wsum((v[0] + v[1]) + (v[2] + v[3])) * (1.f / 256.f);
            v = v - mean;
            const float rstd = rsqrtf(wsum((v[0] * v[0] + v[1] * v[1]) + (v[2] * v[2] + v[3] * v[3])) * (1.f / 256.f) + LN_EPS);
            const f32x4 g = *(const f32x4*)(F.mh_g + hh * 256 + lane * 4); const u32x2 so = *(const u32x2*)(F.OB + o);
            v = v * rstd * g;
            u32x2 w; w.x = pk2(v[0] * bflo(so.x), v[1] * bfhi(so.x)); w.y = pk2(v[2] * bflo(so.y), v[3] * bfhi(so.y));
            *(u32x2*)(F.ACTA + o) = w;
        }
    }
}

constexpr int LP = 136;
constexpr int L_Q = 0, L_K = 34816, L_KT = 69632, L_VT = 104448, L_CT = 117504, L_ARR = 130560;
__device__ __forceinline__ float logsig(float x) { return fminf(x, 0.f) - log1pf(expf(-fabsf(x))); }
__device__ __forceinline__ int chunk_row0(int cc, int dir, int b) { if (cc < 2) { const int ci = dir ? 1 - cc : cc; return MX + b * CTXL + ci * 128; } const int xi = dir ? 33 - cc : cc - 2; return b * SEQ + xi * 128; }
__device__ __forceinline__ unsigned short hsel(const u32x4& v, int i) { const unsigned w = (i >> 1) == 0 ? v.x : (i >> 1) == 1 ? v.y : (i >> 1) == 2 ? v.z : v.w; return (unsigned short)((i & 1) ? (w >> 16) : (w & 0xffffu)); }

__device__ __forceinline__ void mlstm_unit(const Frame& F, int unit, LAS unsigned char* lds, float* HF0, float* HF1) {
    const int tid = threadIdx.x, lane = tid & 63, w = __builtin_amdgcn_readfirstlane(tid >> 6), l15 = lane & 15, q = lane >> 4;
    const int dir = unit >> 7, b = (unit >> 6) & 1, h = (unit >> 3) & 7, sl = unit & 7;
    LAS bf16_t* sQ = (LAS bf16_t*)(lds + L_Q); LAS bf16_t* sK = (LAS bf16_t*)(lds + L_K); LAS bf16_t* sKt = (LAS bf16_t*)(lds + L_KT);
    LAS bf16_t* sVt = (LAS bf16_t*)(lds + L_VT); LAS bf16_t* sCt = (LAS bf16_t*)(lds + L_CT);
    LAS float* sU = (LAS float*)(lds + L_ARR); LAS float* sM = sU + 128; LAS float* sB = sU + 256; LAS float* sW = sU + 384; LAS float* sS = sU + 512;
    float* HF = dir ? HF1 : HF0;
    for (int i = tid; i < 16 * LP; i += NTHREADS) sVt[32 * LP + i] = (i < LP) ? (bf16_t)0x3F80 : (bf16_t)0;
    for (int i = tid; i < 48 * LP; i += NTHREADS) sCt[i] = 0;
    f32x4 accC[3];
#pragma unroll
    for (int nt = 0; nt < 3; ++nt) accC[nt] = (f32x4){0.f, 0.f, 0.f, 0.f};
    float m_run = -1e4f;
    const int rg = tid >> 4, cgp = tid & 15;
    u32x4 kreg[4], qreg[4]; unsigned vreg[4]; float gi[2], gf[2];
    const int kcol = h * 128 + 8 * cgp, vcol = h * 256 + sl * 32 + 2 * cgp, gcol = dir * 16 + h;
#pragma unroll
    for (int r = 0; r < 4; ++r) qreg[r] = (u32x4){0u, 0u, 0u, 0u};
    gi[0] = gi[1] = gf[0] = gf[1] = 0.f;
#define ML_LOAD(cc) do { const int _r0 = chunk_row0((cc), dir, b); \
        _Pragma("unroll") for (int r = 0; r < 4; ++r) { const int j = 4 * rg + r; const size_t row = (size_t)(_r0 + (dir ? 127 - j : j)); \
            kreg[r] = *(const u32x4*)(F.KB + row * DQK + kcol); if ((cc) >= 2) qreg[r] = *(const u32x4*)(F.QB + row * DQK + kcol); vreg[r] = *(const unsigned*)(F.VB + row * DV + vcol); } \
        if (w == 0) { _Pragma("unroll") for (int e = 0; e < 2; ++e) { const int j = 2 * lane + e; const size_t row = (size_t)(_r0 + (dir ? 127 - j : j)); gi[e] = F.GATES[row * 32 + gcol]; gf[e] = F.GATES[row * 32 + gcol + 8]; } } } while (0)
    ML_LOAD(0);
    for (int cc = 0; cc < 34; ++cc) {
        const bool isx = cc >= 2;
        const int row0 = chunk_row0(cc, dir, b);
#pragma unroll
        for (int r = 0; r < 4; ++r) { *(LAS u32x4*)(sK + (4 * rg + r) * LP + 8 * cgp) = kreg[r]; if (isx) *(LAS u32x4*)(sQ + (4 * rg + r) * LP + 8 * cgp) = qreg[r]; }
#pragma unroll
        for (int i = 0; i < 8; ++i) { const int d = 8 * cgp + i; u32x2 wv; wv.x = (unsigned)hsel(kreg[0], i) | ((unsigned)hsel(kreg[1], i) << 16); wv.y = (unsigned)hsel(kreg[2], i) | ((unsigned)hsel(kreg[3], i) << 16);
            *(LAS u32x2*)(sKt + d * LP + 8 * ((rg >> 1) ^ (cgp & 7)) + 4 * (rg & 1)) = wv; }
#pragma unroll
        for (int i = 0; i < 2; ++i) { const int e = 2 * cgp + i; u32x2 wv;
            wv.x = (i ? (vreg[0] >> 16) : (vreg[0] & 0xffffu)) | ((i ? (vreg[1] >> 16) : (vreg[1] & 0xffffu)) << 16);
            wv.y = (i ? (vreg[2] >> 16) : (vreg[2] & 0xffffu)) | ((i ? (vreg[3] >> 16) : (vreg[3] & 0xffffu)) << 16);
            *(LAS u32x2*)(sVt + e * LP + 4 * rg) = wv; }
        if (w == 0) {
            const float lf0 = logsig(gf[0]), lf1 = logsig(gf[1]), p = lf0 + lf1; float incl = p;
#pragma unroll
            for (int o = 1; o < 64; o <<= 1) { const float t = __shfl_up(incl, o); if (lane >= o) incl += t; }
            const float b0 = incl - p + lf0, b1 = incl, u0 = gi[0] - b0, u1 = gi[1] - b1;
            float im = fmaxf(u0, u1);
#pragma unroll
            for (int o = 1; o < 64; o <<= 1) { const float t = __shfl_up(im, o); if (lane >= o) im = fmaxf(im, t); }
            float ex = __shfl_up(im, 1); if (lane == 0) ex = -INFINITY;
            const float pm0 = fmaxf(ex, u0), pm1 = fmaxf(pm0, u1);
            const float g = __shfl(b1, 63), pml = __shfl(pm1, 63);
            const float Ml = fmaxf(m_run, pml);
            sU[2 * lane] = u0; sU[2 * lane + 1] = u1; sM[2 * lane] = fmaxf(m_run, pm0); sM[2 * lane + 1] = fmaxf(m_run, pm1);
            sB[2 * lane] = b0; sB[2 * lane + 1] = b1; sW[2 * lane] = expf(u0 - Ml); sW[2 * lane + 1] = expf(u1 - Ml);
            if (lane == 0) { sS[0] = expf(m_run - Ml); sS[1] = m_run; }
            m_run = g + Ml;
        }
        if (cc + 1 < 34) ML_LOAD(cc + 1);
        __syncthreads();
        if (isx) {
            bf16x8 qf[4];
#pragma unroll
            for (int ks = 0; ks < 4; ++ks) qf[ks] = *(const LAS bf16x8*)(sQ + (16 * w + l15) * LP + 32 * ks + 8 * q);
            f32x4 accO[3];
#pragma unroll
            for (int nt = 0; nt < 3; ++nt) accO[nt] = (f32x4){0.f, 0.f, 0.f, 0.f};
#pragma unroll
            for (int ks = 0; ks < 4; ++ks)
#pragma unroll
                for (int nt = 0; nt < 3; ++nt) { const bf16x8 bfr = *(const LAS bf16x8*)(sCt + (16 * nt + l15) * LP + 32 * ks + 8 * q); accO[nt] = __builtin_amdgcn_mfma_f32_16x16x32_bf16(qf[ks], bfr, accO[nt], 0, 0, 0); }
            const float m_old = sS[1];
#pragma unroll
            for (int i = 0; i < 4; ++i) { const float wi = __expf(m_old - sM[16 * w + 4 * q + i]);
#pragma unroll
                for (int nt = 0; nt < 3; ++nt) accO[nt][i] *= wi; }
            const float Mj = sM[16 * w + l15];
            for (int mt = 0; mt <= w; ++mt) {
                f32x4 s = (f32x4){0.f, 0.f, 0.f, 0.f};
#pragma unroll
                for (int ks = 0; ks < 4; ++ks) { const bf16x8 a = *(const LAS bf16x8*)(sK + (16 * mt + l15) * LP + 32 * ks + 8 * q); s = __builtin_amdgcn_mfma_f32_16x16x32_bf16(a, qf[ks], s, 0, 0, 0); }
                const f32x4 uu = *(const LAS f32x4*)(sU + 16 * mt + 4 * q);
                float pv[4];
#pragma unroll
                for (int i = 0; i < 4; ++i) { const float e = s[i] * __expf(uu[i] - Mj); pv[i] = (mt == w && (4 * q + i) > l15) ? 0.f : e; }
                u32x2 wv; wv.x = pk2(pv[0], pv[1]); wv.y = pk2(pv[2], pv[3]);
                *(LAS u32x2*)(sQ + (16 * w + l15) * LP + 16 * mt + 4 * q) = wv;
            }
            if (!(w & 1)) { u32x2 z; z.x = 0u; z.y = 0u; *(LAS u32x2*)(sQ + (16 * w + l15) * LP + 16 * (w + 1) + 4 * q) = z; }
            const int nks = (w >> 1) + 1;
            for (int ks = 0; ks < nks; ++ks) {
                const bf16x8 a = *(const LAS bf16x8*)(sQ + (16 * w + l15) * LP + 32 * ks + 8 * q);
#pragma unroll
                for (int nt = 0; nt < 3; ++nt) { const bf16x8 bfr = *(const LAS bf16x8*)(sVt + (16 * nt + l15) * LP + 32 * ks + 8 * q); accO[nt] = __builtin_amdgcn_mfma_f32_16x16x32_bf16(a, bfr, accO[nt], 0, 0, 0); }
            }
#pragma unroll
            for (int i = 0; i < 4; ++i) {
                const int j = 16 * w + 4 * q + i;
                const float den = __shfl(accO[2][i], lane & 48);
                const float dd = fmaxf(fabsf(den), __expf(-(sB[j] + sM[j]))), inv = 1.f / dd;
                float* hp = HF + (size_t)(row0 + (dir ? 127 - j : j)) * DV + h * 256 + sl * 32 + l15;
                hp[0] = accO[0][i] * inv; hp[16] = accO[1][i] * inv;
            }
        }
        {
            const float decay = sS[0];
#pragma unroll
            for (int nt = 0; nt < 3; ++nt) accC[nt] = accC[nt] * decay;
            const int d = 16 * w + l15;
#pragma unroll
            for (int ks = 0; ks < 4; ++ks) {
                const u32x4 kv = *(const LAS u32x4*)(sKt + d * LP + 8 * ((4 * ks + q) ^ ((d >> 3) & 7)));
                const f32x4 w0 = *(const LAS f32x4*)(sW + 32 * ks + 8 * q), w1 = *(const LAS f32x4*)(sW + 32 * ks + 8 * q + 4);
                u32x4 av; av.x = pk2(bflo(kv.x) * w0[0], bfhi(kv.x) * w0[1]); av.y = pk2(bflo(kv.y) * w0[2], bfhi(kv.y) * w0[3]);
                av.z = pk2(bflo(kv.z) * w1[0], bfhi(kv.z) * w1[1]); av.w = pk2(bflo(kv.w) * w1[2], bfhi(kv.w) * w1[3]);
                const bf16x8 a = __builtin_bit_cast(bf16x8, av);
#pragma unroll
                for (int nt = 0; nt < 3; ++nt) { const bf16x8 bfr = *(const LAS bf16x8*)(sVt + (16 * nt + l15) * LP + 32 * ks + 8 * q); accC[nt] = __builtin_amdgcn_mfma_f32_16x16x32_bf16(a, bfr, accC[nt], 0, 0, 0); }
            }
        }
        __syncthreads();
#pragma unroll
        for (int nt = 0; nt < 3; ++nt) { u32x2 wv; wv.x = pk2(accC[nt][0], accC[nt][1]); wv.y = pk2(accC[nt][2], accC[nt][3]); *(LAS u32x2*)(sCt + (16 * nt + l15) * LP + 16 * w + 4 * q) = wv; }
    }
#undef ML_LOAD
    __syncthreads();
}

__device__ __forceinline__ void conv_unit(const Frame& F, int unit, LAS unsigned char* lds) {
    const int tid = threadIdx.x, lane = tid & 63, wv = tid >> 6, c0 = 2 * tid;
    const int b = unit >> 7, r = (unit >> 1) & 63, half = unit & 1;
    const bf16_t* U = F.UB + (size_t)(b * SEQ) * DCONV + c0;
    float y0[32], y1[32];
#pragma unroll
    for (int j = 0; j < 32; ++j) { y0[j] = 0.f; y1[j] = 0.f; }
    if (tid < 256) {
        float w0[31], w1[31];
#pragma unroll
        for (int k = 0; k < 31; ++k) { const f32x2v ww = *(const f32x2v*)(F.conv_w + k * DCONV + c0); w0[k] = ww.x; w1[k] = ww.y; }
#pragma unroll
        for (int i = 0; i < 62; ++i) {
            const int col = half * 32 - 15 + i; float u0 = 0.f, u1 = 0.f;
            if (col >= 0 && col < 64) { const unsigned v = *(const unsigned*)(U + (size_t)(r * 64 + col) * DCONV); u0 = bflo(v); u1 = bfhi(v); }
#pragma unroll
            for (int j = 0; j < 32; ++j) { const int k = i - j; if (k >= 0 && k <= 30) { y0[j] += w0[k] * u0; y1[j] += w1[k] * u1; } }
        }
    } else {
        for (int k = 0; k < 31; ++k) {
            const int rr = r + k - 15; if (rr < 0 || rr >= 64) continue;
            const f32x2v ww = *(const f32x2v*)(F.conv_w + k * DCONV + c0);
            const bf16_t* up = U + (size_t)(rr * 64 + half * 32) * DCONV;
#pragma unroll
            for (int j = 0; j < 32; ++j) { const unsigned v = *(const unsigned*)(up + (size_t)j * DCONV); y0[j] += ww.x * bflo(v); y1[j] += ww.y * bfhi(v); }
        }
    }
    const f32x2v cb = *(const f32x2v*)(F.conv_b + c0);
    LAS float* red = (LAS float*)lds;
    LAS float* stat = red + 512;
#pragma unroll
    for (int j = 0; j < 32; ++j) {
        y0[j] += cb.x; y1[j] += cb.y;
        const float s1 = wsum(y0[j] + y1[j]), s2 = wsum(y0[j] * y0[j] + y1[j] * y1[j]);
        if (lane == 0) { red[wv * 64 + j] = s1; red[wv * 64 + 32 + j] = s2; }
    }
    __syncthreads();
    if (tid < 32) { float a = 0.f, q = 0.f;
#pragma unroll
        for (int g = 0; g < 8; ++g) { a += red[g * 64 + tid]; q += red[g * 64 + 32 + tid]; }
        const float mean = a * (1.f / DCONV), var = fmaxf(q * (1.f / DCONV) - mean * mean, 0.f);
        stat[2 * tid] = mean; stat[2 * tid + 1] = rsqrtf(var + LN_EPS); }
    __syncthreads();
    const f32x2v lg = *(const f32x2v*)(F.conv_g + c0), lb = *(const f32x2v*)(F.conv_bb + c0);
    bf16_t* ap = F.AC + (size_t)(b * SEQ + r * 64 + half * 32) * DCONV + c0;
#pragma unroll
    for (int j = 0; j < 32; ++j) {
        const float mean = stat[2 * j], rstd = stat[2 * j + 1];
        const float a0 = (y0[j] - mean) * rstd * lg.x + lb.x, a1 = (y1[j] - mean) * rstd * lg.y + lb.y;
        *(unsigned*)(ap + (size_t)j * DCONV) = pk2(a0 * sigm(a0), a1 * sigm(a1));
    }
    __syncthreads();
}

typedef unsigned v4u_unused __attribute__((ext_vector_type(4)));
#define XB_TMO      128
#define XB_XCNT(j)  (256  + 64 * (j))
#define XB_XSUB(j)  (1280 + 64 * (j))
#define XB_XGEN(j)  (2304 + 64 * (j))
#define XB_TOP      3328
#define XB_TOPGEN   3392
#define XCD_BAR_WORDS 3456
#define XB_SPIN_CAP (1u << 18)

__device__ __forceinline__ unsigned xb_ld(unsigned* p)              { return __hip_atomic_load(p, __ATOMIC_RELAXED, __HIP_MEMORY_SCOPE_AGENT); }
__device__ __forceinline__ unsigned xb_add(unsigned* p, unsigned v) { return __hip_atomic_fetch_add(p, v, __ATOMIC_RELAXED, __HIP_MEMORY_SCOPE_AGENT); }
__device__ __forceinline__ unsigned xb_xcc_id() { return (unsigned)__builtin_amdgcn_s_getreg((3 << 11) | 20) & 0xFu; }
#define XB_SPIN(cond, bar) do { unsigned _sp = 0; while (cond) { __builtin_amdgcn_s_sleep(1); \
    if ((++_sp & 255u) == 0u) { if (xb_ld(&(bar)[XB_TMO])) break; if (_sp > XB_SPIN_CAP) { atomicAdd(&(bar)[XB_TMO], 1u); break; } } } } while (0)

struct XcdBarrier {
    unsigned* bar; unsigned x;
    volatile LAS unsigned* st;
};

__device__ __forceinline__ XcdBarrier xcd_barrier_post(unsigned* bar, volatile LAS unsigned* st) {
    XcdBarrier b; b.bar = bar; b.x = xb_xcc_id(); b.st = st;
    if (threadIdx.x == 0) (void)xb_add(&bar[XB_XCNT(b.x)], 1u);
    return b;
}
__device__ __forceinline__ void xcd_barrier_complete(unsigned* bar, unsigned x, unsigned& nloc, unsigned& nx) {
    const unsigned G = gridDim.x * gridDim.y * gridDim.z;
    unsigned sum, cnt, mine, sp = 0u;
    for (;;) {
        sum = 0u; cnt = 0u; mine = 0u;
#pragma unroll
        for (unsigned j = 0; j < 16; ++j) { const unsigned c = xb_ld(&bar[XB_XCNT(j)]); sum += c; cnt += (c > 0u) ? 1u : 0u; mine = (j == x) ? c : mine; }
        if (sum == G) break;
        __builtin_amdgcn_s_sleep(1);
        if ((++sp & 255u) == 0u) { if (xb_ld(&bar[XB_TMO])) break; if (sp > XB_SPIN_CAP) { atomicAdd(&bar[XB_TMO], 1u); break; } }
    }
    nloc = mine > 0u ? mine : 1u; nx = cnt > 0u ? cnt : 1u;
}

__device__ __forceinline__ void xcd_barrier(const XcdBarrier& b) {
    asm volatile("s_waitcnt vmcnt(0)" ::: "memory");
    __syncthreads();
    if (threadIdx.x == 0) {
        unsigned* bar = b.bar;
        __builtin_amdgcn_s_waitcnt(0);
        unsigned nloc = b.st[0], nx = b.st[1];
        if (nloc == 0u) { xcd_barrier_complete(bar, b.x, nloc, nx); b.st[0] = nloc; b.st[1] = nx; }
        const unsigned old = xb_add(&bar[XB_XSUB(b.x)], 1u);
        const unsigned gen = old / nloc;
        if (old + 1u == (gen + 1u) * nloc) {
            __builtin_amdgcn_fence(__ATOMIC_RELEASE, "agent");
            asm volatile("s_waitcnt vmcnt(0)" ::: "memory");
            const unsigned og = xb_add(&bar[XB_TOP], 1u);
            const unsigned tg = og / nx;
            if (og + 1u == (tg + 1u) * nx) xb_add(&bar[XB_TOPGEN], 1u);
            else XB_SPIN(xb_ld(&bar[XB_TOPGEN]) == tg, bar);
            __builtin_amdgcn_fence(__ATOMIC_ACQUIRE, "agent");
            xb_add(&bar[XB_XGEN(b.x)], 1u);
            asm volatile("s_waitcnt vmcnt(0)" ::: "memory");
        } else {
            XB_SPIN(xb_ld(&bar[XB_XGEN(b.x)]) == gen, bar);
            __builtin_amdgcn_fence(__ATOMIC_ACQUIRE, "agent");
            asm volatile("s_waitcnt vmcnt(0)" ::: "memory");
        }
    }
    __syncthreads();
}


struct Args { const float* in[22]; float* out; unsigned char* ws; int ph_lo, ph_hi; };
constexpr int N_PHASES = 14;

__global__ void __launch_bounds__(NTHREADS, 2) hybrid_fwd(Args args) {
    extern __shared__ __attribute__((aligned(16))) unsigned char lds_raw[];
    LAS unsigned char* lds = (LAS unsigned char*)lds_raw;
    cg::grid_group grid = cg::this_grid();
    Frame F;
    F.x = args.in[0]; F.c = args.in[1]; F.ctx = args.in[2]; F.c_ctx = args.in[3]; F.w_ada = args.in[4]; F.b_ada = args.in[5]; F.w_in = args.in[6]; F.b_in = args.in[7];
    F.mh_g = args.in[8]; F.conv_w = args.in[9]; F.conv_b = args.in[10]; F.conv_g = args.in[11]; F.conv_bb = args.in[12]; F.w_m = args.in[13]; F.w_c = args.in[14]; F.w_o = args.in[15];
    F.f1w13 = args.in[16]; F.f1w2 = args.in[17]; F.f2w13 = args.in[18]; F.f2w2 = args.in[19]; F.pg = args.in[20]; F.pb = args.in[21];
    F.out = args.out; unsigned char* ws = args.ws; F.ws = ws;
    F.mod = (float*)(ws + WS_MOD); F.bperm = (float*)(ws + WS_BPERM); F.OBUF = (float*)(ws + WS_OBUF); F.GATES = (float*)(ws + WS_GATES);
    F.W13A = (bf16_t*)(ws + WS_W13A); F.W2A = (bf16_t*)(ws + WS_W2A); F.WIN = (bf16_t*)(ws + WS_WIN); F.WM = (bf16_t*)(ws + WS_WM); F.WC = (bf16_t*)(ws + WS_WC); F.WO = (bf16_t*)(ws + WS_WO);
    F.W13B = (bf16_t*)(ws + WS_W13B); F.W2B = (bf16_t*)(ws + WS_W2B); F.ACTA = (bf16_t*)(ws + WS_ACTA); F.HBUF = (bf16_t*)(ws + WS_HBUF);
    F.KB = (bf16_t*)(ws + WS_KB); F.VB = (bf16_t*)(ws + WS_VB); F.QB = (bf16_t*)(ws + WS_QB); F.OB = (bf16_t*)(ws + WS_OB); F.UB = (bf16_t*)(ws + WS_UB);
    F.GM = (bf16_t*)(ws + WS_GM); F.GC = (bf16_t*)(ws + WS_GC); F.AC = (bf16_t*)(ws + WS_AC);
    float* PART = (float*)(ws + WS_GM); float* HF0 = (float*)(ws + WS_HBUF); float* HF1 = (float*)(ws + WS_OBUF); float* TB = (float*)(ws + WS_HBUF); bf16_t* MB = (bf16_t*)(ws + WS_VB);
    const int lo = args.ph_lo, hi = args.ph_hi, G = gridDim.x, bx = blockIdx.x;
#define IN(k) (lo <= (k) && (k) < hi)
#ifndef PROBE_SYNC
#define PROBE_SYNC 1
#endif
    XcdBarrier xbar; xbar.bar = (unsigned*)(ws + WS_BAR); xbar.x = 0; xbar.st = (volatile LAS unsigned*)(lds + LDS_BYTES - 64);
    if (threadIdx.x < 2) xbar.st[threadIdx.x] = 0u;
    __syncthreads();
    xbar = xcd_barrier_post((unsigned*)(ws + WS_BAR), (volatile LAS unsigned*)(lds + LDS_BYTES - 64));
#define SEAM(k) do { if (IN(k) && IN((k) + 1)) { for (int _s = 0; _s < PROBE_SYNC; ++_s) { if ((k) == 0) grid.sync(); else xcd_barrier(xbar); } } } while (0)

#ifndef PROBE_P0
#define PROBE_P0 1
#endif
    if (IN(0)) { for (int rep = 0; rep < PROBE_P0; ++rep) p0_prep(F, lds); } SEAM(0);
    if (IN(1)) { p_modin0(F); } SEAM(1);
    if (IN(2)) {
        pg8::Gemm g{F.ACTA, F.W13A, MT, 2 * DFF, D, D}; pg8::StaticOrder S; S.init(MT, 2 * DFF, G, bx); EpiSwiGLU E{F.HBUF};
        pg8::gemm_phase<EpiSwiGLU, pg8::StaticOrder, true, true>(lds, g, S, E); } SEAM(2);
    if (IN(3)) {
        { pg8::Gemm g{F.HBUF, F.W2A, MX, D, DFF, DFF}; pg8::StaticOrder S; S.init(MX, D, G, bx); EpiF32 E{F.OBUF};
          pg8::gemm_phase<EpiF32, pg8::StaticOrder, true, true>(lds, g, S, E); }
        { pg8::Gemm g{F.HBUF, F.W2A, MT, D, DFF / CTX_KSPLIT, DFF}; CtxSplitOrder S; S.G = G; S.c = bx; EpiPart E{PART};
          pg8::gemm_phase<EpiPart, CtxSplitOrder, true, true>(lds, g, S, E); } } SEAM(3);
#ifndef PROBE_P4
#define PROBE_P4 1
#endif
    if (IN(4)) { for (int rep = 0; rep < PROBE_P4; ++rep) p_residual<0>(F, 0.5f, MT, PART); } SEAM(4);
    if (IN(5)) {
        pg8::Gemm g{F.ACTA, F.WIN, MT, NINP, D, D}; InProjOrder S; S.init(G, bx);
        EpiInProj E{F.bperm, F.KB, F.VB, F.QB, F.OB, F.UB, F.GM, F.GC, F.GATES};
        pg8::gemm_phase<EpiInProj, InProjOrder, true, true>(lds, g, S, E); } SEAM(5);
    if (IN(6)) {
#ifndef PROBE_MLSTM
#define PROBE_MLSTM 1
#endif
#ifndef PROBE_CONV
#define PROBE_CONV 1
#endif
        for (int rep = 0; rep < PROBE_MLSTM; ++rep) for (int u = bx; u < 256; u += G) mlstm_unit(F, (u & 31) * 8 + (u >> 5), lds, HF0, HF1);
        for (int rep = 0; rep < PROBE_CONV; ++rep) for (int u = bx; u < 256; u += G) conv_unit(F, u, lds);
    } SEAM(6);
    if (IN(7)) { p_headnorm(F, HF0, HF1); } SEAM(7);
    if (IN(8)) {
        { pg8::Gemm g{F.AC, F.WC, MX, D, DCONV, DCONV}; pg8::StaticOrder S; S.init(MX, D, G, bx); EpiGateT E{TB, F.GC};
          pg8::gemm_phase<EpiGateT, pg8::StaticOrder, true, true>(lds, g, S, E); }
        { pg8::Gemm g{F.ACTA, F.WM, MX, D, DV, DV}; pg8::StaticOrder S; S.init(MX, D, G, bx); EpiMerge E{TB, F.GM, MB};
          pg8::gemm_phase<EpiMerge, pg8::StaticOrder, true, true>(lds, g, S, E); } } SEAM(8);
    if (IN(9)) {
        pg8::Gemm g{MB, F.WO, MX, D, D, D}; pg8::StaticOrder S; S.init(MX, D, G, bx); EpiF32 E{F.OBUF};
        pg8::gemm_phase<EpiF32, pg8::StaticOrder, true, true>(lds, g, S, E); } SEAM(9);
    if (IN(10)) { p_residual<1>(F, 1.0f, MX, PART); } SEAM(10);
    if (IN(11)) {
        pg8::Gemm g{F.ACTA, F.W13B, MX, 2 * DFF, D, D}; pg8::StaticOrder S; S.init(MX, 2 * DFF, G, bx); EpiSwiGLU E{F.HBUF};
        pg8::gemm_phase<EpiSwiGLU, pg8::StaticOrder, true, true>(lds, g, S, E); } SEAM(11);
    if (IN(12)) {
        pg8::Gemm g{F.HBUF, F.W2B, MX, D, DFF, DFF}; pg8::StaticOrder S; S.init(MX, D, G, bx); EpiF32 E{F.OBUF};
        pg8::gemm_phase<EpiF32, pg8::StaticOrder, true, true>(lds, g, S, E); } SEAM(12);
    if (IN(13)) { p_residual<2>(F, 0.5f, MX, PART); }
#undef IN
#undef SEAM
}

#ifndef MK_ONE_LAUNCH
#define MK_ONE_LAUNCH 1
#endif
extern "C" void kernel_launch(void* const* d_in, const int* in_sizes, int n_in, void* d_out, int out_size, void* d_ws, size_t ws_size, hipStream_t stream) {
    static int grid = 0;
    if (grid == 0) {
        if (n_in != 22 || out_size != MX * D || ws_size < WS_END) { fprintf(stderr, "kernel_launch: unexpected shapes (n_in %d out %d ws %zu, need %zu)\n", n_in, out_size, ws_size, (size_t)WS_END); grid = -1; return; }
        int dev = 0, cus = 0, per_cu = 0;
        (void)hipGetDevice(&dev); (void)hipDeviceGetAttribute(&cus, hipDeviceAttributeMultiprocessorCount, dev);
        if (hipFuncSetAttribute((const void*)hybrid_fwd, hipFuncAttributeMaxDynamicSharedMemorySize, LDS_BYTES) != hipSuccess) { fprintf(stderr, "kernel_launch: hipFuncSetAttribute failed\n"); grid = -1; return; }
        if (hipOccupancyMaxActiveBlocksPerMultiprocessor(&per_cu, (const void*)hybrid_fwd, NTHREADS, LDS_BYTES) != hipSuccess || per_cu < 1) { fprintf(stderr, "kernel_launch: occupancy query says %d\n", per_cu); (void)hipGetLastError(); per_cu = 1; }
        grid = cus * per_cu; if (grid > 256) grid = 256;
    }
    if (grid < 0) return;
    Args a{};
    for (int i = 0; i < 22; ++i) a.in[i] = (const float*)d_in[i];
    a.out = (float*)d_out; a.ws = (unsigned char*)d_ws;
    if (hipMemsetAsync((char*)d_ws + WS_BAR, 0, XCD_BAR_WORDS * 4, stream) != hipSuccess) { fprintf(stderr, "kernel_launch: memset of the barrier words failed\n"); return; }
#if MK_ONE_LAUNCH
    a.ph_lo = 0; a.ph_hi = N_PHASES;
    void* kargs[] = {&a};
    const hipError_t e = hipLaunchCooperativeKernel((const void*)hybrid_fwd, dim3(grid), dim3(NTHREADS), kargs, (size_t)LDS_BYTES, stream);
    if (e != hipSuccess) fprintf(stderr, "kernel_launch: cooperative launch failed: %s (grid %d)\n", hipGetErrorString(e), grid);
#else
    for (int p = 0; p < N_PHASES; ++p) { a.ph_lo = p; a.ph_hi = p + 1; hipLaunchKernelGGL(hybrid_fwd, dim3(grid), dim3(NTHREADS), LDS_BYTES, stream, a); }
#endif
}
```

```cpp
#include <hip/hip_runtime.h>
#include <hip/hip_cooperative_groups.h>
#include <cstdio>
#include <cstdint>
namespace cg = cooperative_groups;
namespace pg8 {
#define PG8_LAS __attribute__((address_space(3)))
typedef unsigned short bf16_t;
typedef short bf16x8 __attribute__((ext_vector_type(8)));
typedef float f32x4 __attribute__((ext_vector_type(4)));
typedef unsigned u32x4 __attribute__((ext_vector_type(4)));
constexpr int BM = 256, BK = 64, HALF = 128, HTB = HALF * BK * 2  , STAGE_BYTES = 8 * HTB, NXCD = 8, WGM = 8;

__host__ __device__ __forceinline__ int lds_byte(int r, int c) { const int st = (r >> 4) * 2 + (c >> 5), rr = r & 15, cc = c & 31, ob = rr * 64 + cc * 2; return st * 1024 + (ob ^ (((ob >> 9) & 1) << 5)); }
__host__ __device__ __forceinline__ void stage_rc(int b, int& R, int& C) { const int st = b / 1024, sb = b % 1024, swz = sb ^ (((sb >> 9) & 1) << 5); R = (st >> 1) * 16 + swz / 64; C = (st & 1) * 32 + (swz % 64) / 2; }
__host__ __device__ __forceinline__ int perm32(int rho) { const int n = rho >> 4, i = rho & 15; return 8 * (i >> 2) + 4 * n + (i & 3); }

struct Unit { int pm, pn, kp, nt, g, keep, orow; };
struct Gemm { const bf16_t* A; const bf16_t* Bt; int M, N, K, ld; const bf16_t* A1; const bf16_t* Bt1; };

struct StaticOrder {
    int nM, nN, nwg, G, c;
    __host__ __device__ void init(int M, int N, int G_, int c_) { nM = M / BM; nN = N / BM; nwg = nM * nN; G = G_; c = c_; }
    __host__ __device__ bool next(int i, Unit& u) const {
        const long L = (long)i * G + c; if (L >= nwg) return false;
        int wgid = (int)L; { const int q = nwg / NXCD, r = nwg % NXCD, xcd = wgid % NXCD, off = wgid / NXCD; wgid = (xcd < r ? xcd * (q + 1) : r * (q + 1) + (xcd - r) * q) + off; }
        const int nig = WGM * nN, gid = wgid / nig, fm = gid * WGM, gsz = (nM - fm) < WGM ? (nM - fm) : WGM;
        u.pm = fm + ((wgid % nig) % gsz); u.pn = (wgid % nig) / gsz; u.kp = 0; u.nt = 0; u.g = 0; u.keep = 0; u.orow = u.pm * BM; return true;
    }
    __device__ __forceinline__ void a_ready(const Unit&) const {}
    __device__ __forceinline__ void done(const Unit&) const {}
};
__device__ __forceinline__ unsigned cvt_pk_bf16(float lo, float hi) { unsigned r; asm volatile("v_cvt_pk_bf16_f32 %0, %1, %2" : "=v"(r) : "v"(lo), "v"(hi)); return r; }
typedef float f32x2 __attribute__((ext_vector_type(2)));
template <class Epi, class Sched, bool ALIGN_EPI = false, bool SP2 = false>
__device__ __forceinline__ void gemm_phase(PG8_LAS unsigned char* lds, const Gemm g, const Sched& S, const Epi& E) {
    const int tid = threadIdx.x, wid = __builtin_amdgcn_readfirstlane(tid >> 6), lane = tid & 63, wr = wid >> 2, wc = wid & 3, fr = lane & 15, fq = lane >> 4;
    const int K = g.K, nt = K / BK;
    unsigned voffA[2], voffB[2];
#pragma unroll
    for (int i = 0; i < 2; ++i) { int R, C; stage_rc(tid * 16 + i * 8192, R, C); const int Rb = Epi::PERM ? ((R & ~31) + perm32(R & 31)) : R;
        voffA[i] = (unsigned)(R * g.ld + C) * 2u; voffB[i] = (unsigned)(Rb * g.ld + C) * 2u; }
    const size_t kstep = (size_t)(BK * 2);
    const size_t hstep = (size_t)HALF * g.ld * 2;
    const size_t tstep = 2 * hstep;
    const unsigned ldsw = (unsigned)wid * 1024u;
    const int aoff = lds_byte(wr * 64 + fr, fq * 8), boff = lds_byte(wc * 32 + fr, fq * 8);
#define PG8_SA(b, h) (((b) * 2 + (h)) * HTB)
#define PG8_SB(b, h) ((4 + (b) * 2 + (h)) * HTB)
#define PG8_STAGE(bufoff, gbase, voff) do { _Pragma("unroll") for (int _i = 0; _i < 2; ++_i) \
        __builtin_amdgcn_global_load_lds((const unsigned*)((const char*)(gbase) + (voff)[_i]), (PG8_LAS unsigned*)(lds + (bufoff) + ldsw + _i * 8192), 16, 0, 0); } while (0)
#define PG8_LDA(dst, b, h) do { _Pragma("unroll") for (int m = 0; m < 4; ++m) _Pragma("unroll") for (int k = 0; k < 2; ++k) dst[m][k] = *(const PG8_LAS bf16x8*)(lds + PG8_SA(b, h) + aoff + m * 2048 + k * 1024); } while (0)
#define PG8_LDB(dst, b, h) do { _Pragma("unroll") for (int n = 0; n < 2; ++n) _Pragma("unroll") for (int k = 0; k < 2; ++k) dst[n][k] = *(const PG8_LAS bf16x8*)(lds + PG8_SB(b, h) + boff + n * 2048 + k * 1024); } while (0)
#define PG8_MMA(ai, bj, At, Bt) do { __builtin_amdgcn_s_setprio(1); _Pragma("unroll") for (int m = 0; m < 4; ++m) _Pragma("unroll") for (int n = 0; n < 2; ++n) _Pragma("unroll") for (int k = 0; k < 2; ++k) \
        acc[ai][bj][m][n] = __builtin_amdgcn_mfma_f32_16x16x32_bf16(Bt[n][k], At[m][k], acc[ai][bj][m][n], 0, 0, 0); __builtin_amdgcn_s_setprio(0); } while (0)
#define PG8_WAIT_V(n) asm volatile("s_waitcnt vmcnt(" #n ")" ::: "memory")
#define PG8_WAIT_L(n) asm volatile("s_waitcnt lgkmcnt(" #n ")" ::: "memory")
#define PG8_BAR __builtin_amdgcn_s_barrier()
#define PG8_SCHED __builtin_amdgcn_sched_barrier(0)
    Unit cur, nxt; int ui = 0;
    if (!S.next(0, cur)) return;
    f32x4 acc[2][2][4][2];
#pragma unroll
    for (int a = 0; a < 2; ++a)
#pragma unroll
        for (int b = 0; b < 2; ++b)
#pragma unroll
            for (int m = 0; m < 4; ++m)
#pragma unroll
                for (int n = 0; n < 2; ++n) acc[a][b][m][n] = (f32x4){0.f, 0.f, 0.f, 0.f};
    bf16x8 At[4][2], B0[2][2], B1[2][2];
    const char* cA = (const char*)(cur.g ? g.A1 : g.A) + (size_t)cur.pm * tstep + (size_t)cur.kp * 2; const char* cB = (const char*)(cur.g ? g.Bt1 : g.Bt) + (size_t)cur.pn * tstep + (size_t)cur.kp * 2;
    S.a_ready(cur);
    if constexpr (SP2) {
        PG8_STAGE(PG8_SB(0, 0), cB, voffB); PG8_STAGE(PG8_SB(0, 1), cB + hstep, voffB); PG8_STAGE(PG8_SA(0, 0), cA, voffA); PG8_STAGE(PG8_SA(0, 1), cA + hstep, voffA);
        if (wr == 1) PG8_BAR;
        PG8_WAIT_V(2); PG8_BAR;
        PG8_STAGE(PG8_SB(1, 0), cB + kstep, voffB); PG8_STAGE(PG8_SA(1, 0), cA + kstep, voffA); PG8_STAGE(PG8_SB(1, 1), cB + hstep + kstep, voffB);
        PG8_WAIT_V(6); PG8_BAR;
    } else {
        PG8_STAGE(PG8_SB(0, 0), cB, voffB); PG8_STAGE(PG8_SA(0, 0), cA, voffA); PG8_STAGE(PG8_SB(0, 1), cB + hstep, voffB); PG8_STAGE(PG8_SA(0, 1), cA + hstep, voffA);
        if (wr == 1) PG8_BAR;
        PG8_WAIT_V(4); PG8_BAR;
        PG8_STAGE(PG8_SB(1, 0), cB + kstep, voffB); PG8_STAGE(PG8_SA(1, 0), cA + kstep, voffA); PG8_STAGE(PG8_SB(1, 1), cB + hstep + kstep, voffB);
        PG8_WAIT_V(6); PG8_BAR;
    }
    for (;;) {
        const bool has_next = S.next(ui + 1, nxt);
        const char* nA = has_next ? (const char*)(nxt.g ? g.A1 : g.A) + (size_t)nxt.pm * tstep + (size_t)nxt.kp * 2 : cA; const char* nB = has_next ? (const char*)(nxt.g ? g.Bt1 : g.Bt) + (size_t)nxt.pn * tstep + (size_t)nxt.kp * 2 : cB;
        const int ntc = cur.nt > 0 ? cur.nt : nt;
        for (int t = 0; t < ntc; t += 2) {
            const bool last = (t == ntc - 2);
            const char* a1 = cA + (size_t)(t + 1) * kstep;
            const char* a2 = last ? nA : cA + (size_t)(t + 2) * kstep; const char* b2 = last ? nB : cB + (size_t)(t + 2) * kstep;
            const char* a3 = a2 + kstep; const char* b3 = b2 + kstep;
            if (last && has_next) S.a_ready(nxt);
            if constexpr (SP2) {
            PG8_LDB(B0, 0, 0); PG8_LDB(B1, 0, 1); PG8_SCHED; PG8_LDA(At, 0, 0); PG8_STAGE(PG8_SA(1, 1), a1 + hstep, voffA);
            PG8_WAIT_V(8); PG8_WAIT_L(0); PG8_BAR; PG8_MMA(0, 0, At, B0); PG8_MMA(0, 1, At, B1); PG8_BAR; PG8_SCHED;
            PG8_LDA(At, 0, 1); PG8_STAGE(PG8_SB(0, 0), b2, voffB); PG8_STAGE(PG8_SB(0, 1), b2 + hstep, voffB); PG8_STAGE(PG8_SA(0, 0), a2, voffA);
            PG8_WAIT_V(8); PG8_WAIT_L(0); PG8_BAR; PG8_MMA(1, 0, At, B0); PG8_MMA(1, 1, At, B1); PG8_BAR; PG8_SCHED;
            PG8_LDB(B0, 1, 0); PG8_LDB(B1, 1, 1); PG8_SCHED; PG8_LDA(At, 1, 0); PG8_STAGE(PG8_SA(0, 1), a2 + hstep, voffA);
            PG8_WAIT_V(8); PG8_WAIT_L(0); PG8_BAR; PG8_MMA(0, 0, At, B0); PG8_MMA(0, 1, At, B1); PG8_BAR; PG8_SCHED;
            PG8_LDA(At, 1, 1); PG8_STAGE(PG8_SB(1, 0), b3, voffB); PG8_STAGE(PG8_SB(1, 1), b3 + hstep, voffB); PG8_STAGE(PG8_SA(1, 0), a3, voffA);
            PG8_WAIT_V(8); PG8_WAIT_L(0); PG8_BAR; PG8_MMA(1, 0, At, B0); PG8_MMA(1, 1, At, B1); PG8_BAR; PG8_SCHED;
            } else {
            PG8_LDB(B0, 0, 0); PG8_SCHED; PG8_LDA(At, 0, 0); PG8_STAGE(PG8_SA(1, 1), a1 + hstep, voffA);
            PG8_WAIT_L(8); PG8_BAR; PG8_WAIT_L(0); PG8_MMA(0, 0, At, B0); PG8_BAR; PG8_SCHED;
            PG8_LDB(B1, 0, 1); PG8_STAGE(PG8_SB(0, 0), b2, voffB);
            PG8_BAR; PG8_WAIT_L(0); PG8_MMA(0, 1, At, B1); PG8_BAR;
            PG8_LDA(At, 0, 1); PG8_STAGE(PG8_SA(0, 0), a2, voffA);
            PG8_BAR; PG8_WAIT_L(0); PG8_MMA(1, 0, At, B0); PG8_BAR; PG8_SCHED;
            PG8_STAGE(PG8_SB(0, 1), b2 + hstep, voffB);
            PG8_WAIT_V(6); PG8_BAR; PG8_MMA(1, 1, At, B1); PG8_BAR;
            PG8_LDB(B0, 1, 0); PG8_SCHED; PG8_LDA(At, 1, 0); PG8_STAGE(PG8_SA(0, 1), a2 + hstep, voffA);
            PG8_WAIT_L(8); PG8_BAR; PG8_WAIT_L(0); PG8_MMA(0, 0, At, B0); PG8_BAR; PG8_SCHED;
            PG8_LDB(B1, 1, 1); PG8_STAGE(PG8_SB(1, 0), b3, voffB);
            PG8_BAR; PG8_WAIT_L(0); PG8_MMA(0, 1, At, B1); PG8_BAR;
            PG8_LDA(At, 1, 1); PG8_STAGE(PG8_SA(1, 0), a3, voffA);
            PG8_BAR; PG8_WAIT_L(0); PG8_MMA(1, 0, At, B0); PG8_BAR; PG8_SCHED;
            PG8_STAGE(PG8_SB(1, 1), b3 + hstep, voffB);
            PG8_WAIT_V(6); PG8_BAR; PG8_MMA(1, 1, At, B1); PG8_BAR;
            }
        }
        if constexpr (ALIGN_EPI) { if (wr == 0) PG8_BAR; }
        if constexpr (!Epi::AFTER_DRAIN) { E(acc, cur, wr, wc, fr, fq); S.done(cur); }
        if (!has_next) break;
        if (!cur.keep) {
#pragma unroll
        for (int a = 0; a < 2; ++a)
#pragma unroll
            for (int b = 0; b < 2; ++b)
#pragma unroll
                for (int m = 0; m < 4; ++m)
#pragma unroll
                    for (int n = 0; n < 2; ++n) acc[a][b][m][n] = (f32x4){0.f, 0.f, 0.f, 0.f};
        }
        cur = nxt; cA = nA; cB = nB; ++ui;
        if constexpr (ALIGN_EPI) { if (wr == 1) PG8_BAR; }
    }
    PG8_WAIT_V(0);
    if constexpr (!ALIGN_EPI) { if (wr == 0) PG8_BAR; }
    PG8_BAR;
    if constexpr (Epi::AFTER_DRAIN) { E.fused(acc, cur, wr, wc, fr, fq, lds, wid, lane); S.done(cur); }
#undef PG8_SA
#undef PG8_SB
#undef PG8_STAGE
#undef PG8_LDA
#undef PG8_LDB
#undef PG8_MMA
#undef PG8_WAIT_V
#undef PG8_WAIT_L
#undef PG8_BAR
#undef PG8_SCHED
}
}

using pg8::f32x4; using pg8::bf16x8; using pg8::u32x4; using pg8::bf16_t;
#define LAS __attribute__((address_space(3)))
typedef unsigned u32x2 __attribute__((ext_vector_type(2)));
typedef float f32x2v __attribute__((ext_vector_type(2)));

constexpr int D = 2048, SEQ = 4096, MX = 8192, MC = 512, MT = 8704, CTXL = 256;
constexpr int NH = 8, DQK = 1024, DV = 2048, DCONV = 1024, DFF = 5632;
constexpr int NINP = 12544;
constexpr float LN_EPS = 1e-5f, ALPHA = 1.189207115002721f  , QSCALE = 0.08838834764831845f;
constexpr int NWAVES = 8, NTHREADS = 512;

constexpr size_t MiB = 1u << 20;
constexpr size_t WS_MOD = 4096, WS_BAR = 256 * 1024, WS_BPERM = 512 * 1024;
constexpr size_t WS_W13A = 1 * MiB, WS_W2A = 45 * MiB, WS_WIN = 67 * MiB, WS_WM = 116 * MiB, WS_WC = 124 * MiB, WS_WO = 128 * MiB, WS_W13B = 136 * MiB, WS_W2B = 180 * MiB;
constexpr size_t WS_ACTA = 202 * MiB, WS_HBUF = 236 * MiB, WS_OBUF = 330 * MiB;
constexpr size_t WS_KB = 402 * MiB, WS_VB = 419 * MiB, WS_QB = 453 * MiB, WS_OB = 469 * MiB, WS_UB = 501 * MiB, WS_GM = 517 * MiB, WS_GC = 549 * MiB, WS_GATES = 581 * MiB, WS_AC = 583 * MiB;
constexpr size_t WS_END = 599 * MiB;

constexpr int LDS_BYTES = 135168;

__device__ __forceinline__ float bf2f(unsigned b) { return __uint_as_float(b << 16); }
__device__ __forceinline__ float bflo(unsigned w) { return __uint_as_float(w << 16); }
__device__ __forceinline__ float bfhi(unsigned w) { return __uint_as_float(w & 0xffff0000u); }
__device__ __forceinline__ unsigned pk2(float lo, float hi) { return pg8::cvt_pk_bf16(lo, hi); }
__device__ __forceinline__ float sigm(float x) { return __builtin_amdgcn_rcpf(1.f + __expf(-x)); }
__device__ __forceinline__ float wsum(float v) {
#pragma unroll
    for (int o = 32; o >= 1; o >>= 1) v += __shfl_xor(v, o);
    return v;
}

struct Frame {
    const float *x, *c, *ctx, *c_ctx, *w_ada, *b_ada, *w_in, *b_in, *mh_g, *conv_w, *conv_b, *conv_g, *conv_bb, *w_m, *w_c, *w_o, *f1w13, *f1w2, *f2w13, *f2w2, *pg, *pb;
    float* out; unsigned char* ws;
    float *mod, *bperm, *OBUF, *GATES;
    bf16_t *W13A, *W2A, *WIN, *WM, *WC, *WO, *W13B, *W2B, *ACTA, *HBUF, *KB, *VB, *QB, *OB, *UB, *GM, *GC, *AC;
};

struct EpiSwiGLU {
    static constexpr bool PERM = true, AFTER_DRAIN = false;
    bf16_t* H;
    __device__ __forceinline__ void operator()(const f32x4 (&acc)[2][2][4][2], const pg8::Unit& u, int wr, int wc, int fr, int fq) const {
        const int row0 = u.pm * 256 + wr * 64 + fr, col0 = u.pn * 128 + wc * 32 + 8 * fq;
#pragma unroll
        for (int ai = 0; ai < 2; ++ai)
#pragma unroll
            for (int m = 0; m < 4; ++m) {
                bf16_t* p = H + (size_t)(row0 + ai * 128 + m * 16) * DFF + col0;
                float h[8];
#pragma unroll
                for (int n = 0; n < 2; ++n)
#pragma unroll
                    for (int j = 0; j < 4; ++j) { const float a = acc[ai][0][m][n][j], g = acc[ai][1][m][n][j]; h[n * 4 + j] = a * sigm(a) * g; }
                u32x4 w; w.x = pk2(h[0], h[1]); w.y = pk2(h[2], h[3]); w.z = pk2(h[4], h[5]); w.w = pk2(h[6], h[7]);
                *(u32x4*)p = w;
            }
    }
};
struct EpiNull {
    static constexpr bool PERM = true, AFTER_DRAIN = false;
    float* C;
    __device__ __forceinline__ void operator()(const f32x4 (&acc)[2][2][4][2], const pg8::Unit& u, int wr, int wc, int fr, int fq) const {
        float s = 0.f;
#pragma unroll
        for (int ai = 0; ai < 2; ++ai)
#pragma unroll
            for (int bj = 0; bj < 2; ++bj)
#pragma unroll
                for (int m = 0; m < 4; ++m)
#pragma unroll
                    for (int n = 0; n < 2; ++n) s += acc[ai][bj][m][n][0] + acc[ai][bj][m][n][1] + acc[ai][bj][m][n][2] + acc[ai][bj][m][n][3];
        if (s == 1.2345678e30f) C[u.pm] = s;
    }
};
struct EpiF32 {
    static constexpr bool PERM = false, AFTER_DRAIN = false;
    float* C;
    __device__ __forceinline__ void operator()(const f32x4 (&acc)[2][2][4][2], const pg8::Unit& u, int wr, int wc, int fr, int fq) const {
        const int row0 = u.orow + wr * 64 + fr, col0 = u.pn * 256 + wc * 32 + 4 * fq;
#pragma unroll
        for (int ai = 0; ai < 2; ++ai)
#pragma unroll
            for (int m = 0; m < 4; ++m) { float* rowp = C + (size_t)(row0 + ai * 128 + m * 16) * D + col0;
#pragma unroll
                for (int bj = 0; bj < 2; ++bj)
#pragma unroll
                    for (int n = 0; n < 2; ++n) *(f32x4*)(rowp + bj * 128 + n * 16) = acc[ai][bj][m][n]; }
    }
};
struct EpiInProj {
    static constexpr bool PERM = true, AFTER_DRAIN = false;
    const float* bias; bf16_t *KB, *VB, *QB, *OB, *UB, *GM, *GC; float* GATES;
    __device__ __forceinline__ void operator()(const f32x4 (&acc)[2][2][4][2], const pg8::Unit& u, int wr, int wc, int fr, int fq) const {
        const int pn = u.pn, row0 = u.pm * 256 + wr * 64 + fr, lc0 = wc * 32 + 8 * fq;
        if (pn == 48) {
            if (wc == 0) {
                const f32x4 b0 = *(const f32x4*)(bias + 12288 + 8 * fq), b1 = *(const f32x4*)(bias + 12288 + 8 * fq + 4);
#pragma unroll
                for (int ai = 0; ai < 2; ++ai)
#pragma unroll
                    for (int m = 0; m < 4; ++m) { float* p = GATES + (size_t)(row0 + ai * 128 + m * 16) * 32 + 8 * fq;
                        *(f32x4*)p = acc[ai][0][m][0] + b0; *(f32x4*)(p + 4) = acc[ai][0][m][1] + b1; }
            }
            return;
        }
        if (pn >= 24 && pn < 32) {
            const int col = (pn - 24) * 128 + lc0;
            const f32x4 ba0 = *(const f32x4*)(bias + pn * 256 + lc0), ba1 = *(const f32x4*)(bias + pn * 256 + lc0 + 4);
            const f32x4 bg0 = *(const f32x4*)(bias + pn * 256 + 128 + lc0), bg1 = *(const f32x4*)(bias + pn * 256 + 128 + lc0 + 4);
#pragma unroll
            for (int ai = 0; ai < 2; ++ai)
#pragma unroll
                for (int m = 0; m < 4; ++m) {
                    const f32x4 a0 = acc[ai][0][m][0] + ba0, a1 = acc[ai][0][m][1] + ba1, g0 = acc[ai][1][m][0] + bg0, g1 = acc[ai][1][m][1] + bg1;
                    u32x4 w; w.x = pk2(a0[0] * sigm(g0[0]), a0[1] * sigm(g0[1])); w.y = pk2(a0[2] * sigm(g0[2]), a0[3] * sigm(g0[3]));
                    w.z = pk2(a1[0] * sigm(g1[0]), a1[1] * sigm(g1[1])); w.w = pk2(a1[2] * sigm(g1[2]), a1[3] * sigm(g1[3]));
                    *(u32x4*)(UB + (size_t)(row0 + ai * 128 + m * 16) * DCONV + col) = w;
                }
            return;
        }
        bf16_t* dst; int ldc, cb, mode;
        if (pn < 4) { dst = KB; ldc = DQK; cb = pn * 256; mode = 0; }
        else if (pn < 12) { dst = VB; ldc = DV; cb = (pn - 4) * 256; mode = 0; }
        else if (pn < 16) { dst = QB; ldc = DQK; cb = (pn - 12) * 256; mode = 1; }
        else if (pn < 24) { dst = OB; ldc = DV; cb = (pn - 16) * 256; mode = 2; }
        else if (pn < 40) { dst = GM; ldc = D; cb = (pn - 32) * 256; mode = 2; }
        else { dst = GC; ldc = D; cb = (pn - 40) * 256; mode = 2; }
#pragma unroll
        for (int bj = 0; bj < 2; ++bj) {
            const f32x4 b0 = *(const f32x4*)(bias + pn * 256 + bj * 128 + lc0), b1 = *(const f32x4*)(bias + pn * 256 + bj * 128 + lc0 + 4);
#pragma unroll
            for (int ai = 0; ai < 2; ++ai)
#pragma unroll
                for (int m = 0; m < 4; ++m) {
                    f32x4 v0 = acc[ai][bj][m][0] + b0, v1 = acc[ai][bj][m][1] + b1;
                    if (mode == 1) { v0 = v0 * QSCALE; v1 = v1 * QSCALE; }
                    if (mode == 2) {
#pragma unroll
                        for (int j = 0; j < 4; ++j) { v0[j] = sigm(v0[j]); v1[j] = sigm(v1[j]); } }
                    u32x4 w; w.x = pk2(v0[0], v0[1]); w.y = pk2(v0[2], v0[3]); w.z = pk2(v1[0], v1[1]); w.w = pk2(v1[2], v1[3]);
                    *(u32x4*)(dst + (size_t)(row0 + ai * 128 + m * 16) * ldc + cb + bj * 128 + lc0) = w;
                }
        }
    }
};
struct InProjOrder {
    pg8::StaticOrder so;
    __device__ void init(int G, int c) { so.init(MX, NINP, G, c); }
    __device__ bool next(int i, pg8::Unit& u) const {
        if (so.next(i, u)) return true;
        const long L = (long)i * so.G + so.c - so.nwg; if (L >= 26) return false;
        const int j = (int)L % 13; u.pm = 32 + (int)L / 13; u.pn = j < 12 ? j : 48; u.kp = 0; u.nt = 0; u.g = 0; u.keep = 0; u.orow = u.pm * 256; return true;
    }
    __device__ __forceinline__ void a_ready(const pg8::Unit&) const {}
    __device__ __forceinline__ void done(const pg8::Unit&) const {}
};

constexpr int CTX_KSPLIT = 11;
struct FfnDownOrder {
    pg8::StaticOrder so;
    __device__ void init(int G, int c) { so.init(MX, D, G, c); }
    __device__ bool next(int i, pg8::Unit& u) const {
        if (so.next(i, u)) return true;
        const long L = (long)i * so.G + so.c - so.nwg; if (L >= 16 * CTX_KSPLIT) return false;
        const int t = (int)L / CTX_KSPLIT, p = (int)L % CTX_KSPLIT; u.kp = p * (DFF / CTX_KSPLIT); u.pm = 32 + (t >> 3); u.pn = t & 7; u.nt = DFF / CTX_KSPLIT / 64; u.g = 0; u.keep = 0; u.orow = MX + p * MC + (t >> 3) * 256; return true;
    }
    __device__ __forceinline__ void a_ready(const pg8::Unit&) const {}
    __device__ __forceinline__ void done(const pg8::Unit&) const {}
};
struct MergeOrder {
    pg8::StaticOrder so;
    __device__ void init(int G, int c) { so.init(MX, D, G, c); }
    __device__ bool next(int i, pg8::Unit& u) const {
        if (!so.next(i >> 1, u)) return false;
        if (i & 1) { u.g = 1; u.nt = DV / 64; u.keep = 0; } else { u.g = 0; u.nt = DCONV / 64; u.keep = 1; }
        return true;
    }
    __device__ __forceinline__ void a_ready(const pg8::Unit&) const {}
    __device__ __forceinline__ void done(const pg8::Unit&) const {}
};
struct EpiMerge2 {
    static constexpr bool PERM = true, AFTER_DRAIN = false;
    const bf16_t* GC; const bf16_t* GM; bf16_t* O;
    __device__ __forceinline__ void operator()(f32x4 (&acc)[2][2][4][2], const pg8::Unit& u, int wr, int wc, int fr, int fq) const {
        const int row0 = u.pm * 256 + wr * 64 + fr, col0 = u.pn * 256 + wc * 32 + 8 * fq;
#pragma unroll
        for (int ai = 0; ai < 2; ++ai)
#pragma unroll
            for (int m = 0; m < 4; ++m)
#pragma unroll
                for (int bj = 0; bj < 2; ++bj) {
                    const size_t o = (size_t)(row0 + ai * 128 + m * 16) * D + col0 + bj * 128;
                    const u32x4 gm = *(const u32x4*)(GM + o);
                    float g[8]; g[0] = bflo(gm.x); g[1] = bfhi(gm.x); g[2] = bflo(gm.y); g[3] = bfhi(gm.y); g[4] = bflo(gm.z); g[5] = bfhi(gm.z); g[6] = bflo(gm.w); g[7] = bfhi(gm.w);
                    if (u.g == 0) {
                        const u32x4 gc = *(const u32x4*)(GC + o);
                        float c[8]; c[0] = bflo(gc.x); c[1] = bfhi(gc.x); c[2] = bflo(gc.y); c[3] = bfhi(gc.y); c[4] = bflo(gc.z); c[5] = bfhi(gc.z); c[6] = bflo(gc.w); c[7] = bfhi(gc.w);
#pragma unroll
                        for (int j = 0; j < 4; ++j) { acc[ai][bj][m][0][j] *= c[j] / g[j]; acc[ai][bj][m][1][j] *= c[4 + j] / g[4 + j]; }
                    } else {
                        const f32x4 a0 = acc[ai][bj][m][0], a1 = acc[ai][bj][m][1];
                        u32x4 w; w.x = pk2(a0[0] * g[0], a0[1] * g[1]); w.y = pk2(a0[2] * g[2], a0[3] * g[3]); w.z = pk2(a1[0] * g[4], a1[1] * g[5]); w.w = pk2(a1[2] * g[6], a1[3] * g[7]);
                        *(u32x4*)(O + o) = w;
                    }
                }
    }
};

__device__ __forceinline__ int map_col(int mode, int n) {
    if (mode == 0) return n;
    if (mode == 1) { const int t = n >> 8, i = n & 255; return i < 128 ? 128 * t + i : DFF + 128 * t + (i - 128); }
    if (n < 3072) return n;
    if (n < 4096) return 3104 + (n - 3072);
    if (n < 6144) return 4128 + (n - 4096);
    if (n < 8192) { const int t = (n - 6144) >> 8, i = (n - 6144) & 255; return i < 128 ? 6176 + 128 * t + i : 6176 + 1024 + 128 * t + (i - 128); }
    if (n < 12288) return 8224 + (n - 8192);
    if (n < 12320) return 3072 + (n - 12288);
    return -1;
}
__device__ __forceinline__ void adaln_group(const Frame& F, int grp, LAS unsigned char* lds) {
    LAS float* sc = (LAS float*)lds;
    LAS float* red = (LAS float*)(lds + 3 * 2048 * 4);
    const int tid = threadIdx.x;
    for (int i = tid; i < 3 * 2048; i += NTHREADS) { const int r = i >> 11, k = i & 2047; const float v = r < 2 ? F.c[r * 2048 + k] : F.c_ctx[k]; sc[i] = v * (1.f / (1.f + expf(-v))); }
    __syncthreads();
    const int c4 = tid % 18, kg = tid / 18, n0 = grp * 72 + c4 * 4;
    f32x4 a0 = {0.f, 0.f, 0.f, 0.f}, a1 = a0, a2 = a0;
    if (kg < 28) {
        const float* wp = F.w_ada + n0;
        int k = kg;
        for (; k + 28 * 7 < 2048; k += 28 * 8) {
            f32x4 wv[8];
#pragma unroll
            for (int u = 0; u < 8; ++u) wv[u] = __builtin_nontemporal_load((const f32x4*)(wp + (size_t)(k + 28 * u) * (9 * D)));
#pragma unroll
            for (int u = 0; u < 8; ++u) { const int kk = k + 28 * u; a0 += wv[u] * sc[kk]; a1 += wv[u] * sc[2048 + kk]; a2 += wv[u] * sc[4096 + kk]; }
        }
        for (; k < 2048; k += 28) { const f32x4 w = __builtin_nontemporal_load((const f32x4*)(wp + (size_t)k * (9 * D))); a0 += w * sc[k]; a1 += w * sc[2048 + k]; a2 += w * sc[4096 + k]; }
        LAS float* p = red + (kg * 18 + c4) * 12;
        *(LAS f32x4*)p = a0; *(LAS f32x4*)(p + 4) = a1; *(LAS f32x4*)(p + 8) = a2;
    }
    __syncthreads();
    if (tid < 216) {
        const int cc = tid / 12, e = tid % 12, r = e >> 2, j = e & 3; float s = 0.f;
        for (int g = 0; g < 28; ++g) s += red[(g * 18 + cc) * 12 + e];
        const int n = grp * 72 + cc * 4 + j;
        F.mod[r * (9 * D) + n] = s + F.b_ada[n];
    }
    __syncthreads();
}
__device__ __forceinline__ void cvt_tile(const float* W, int Nsrc, bf16_t* Bt, int ldb, int k0, int n0, int mode) {
    const int tid = threadIdx.x, n4 = tid & 63, kgrp = tid >> 6;
    const int n = n0 + 4 * n4, src = map_col(mode, n), kb = k0 + 8 * kgrp;
    f32x4 v[8];
    if (src >= 0) {
#pragma unroll
        for (int i = 0; i < 8; ++i) v[i] = __builtin_nontemporal_load((const f32x4*)(W + (size_t)(kb + i) * Nsrc + src));
    } else {
#pragma unroll
        for (int i = 0; i < 8; ++i) v[i] = (f32x4){0.f, 0.f, 0.f, 0.f};
    }
#pragma unroll
    for (int c = 0; c < 4; ++c) { u32x4 w; w.x = pk2(v[0][c], v[1][c]); w.y = pk2(v[2][c], v[3][c]); w.z = pk2(v[4][c], v[5][c]); w.w = pk2(v[6][c], v[7][c]);
        *(u32x4*)(Bt + (size_t)(n + c) * ldb + kb) = w; }
}
__device__ __forceinline__ void p0_prep(const Frame& F, LAS unsigned char* lds) {
    for (int g = blockIdx.x; g < 256; g += gridDim.x) adaln_group(F, g, lds);
    for (int i = blockIdx.x * NTHREADS + threadIdx.x; i < NINP; i += gridDim.x * NTHREADS) { const int s = map_col(2, i); F.bperm[i] = s >= 0 ? F.b_in[s] : 0.f; }
    constexpr int T0 = 1408, T1 = 704, T2 = 1568, T3 = 256, T4 = 128, T5 = 256, T6 = 1408, T7 = 704, TT = T0 + T1 + T2 + T3 + T4 + T5 + T6 + T7;
    for (int T = blockIdx.x; T < TT; T += gridDim.x) {
        int t = T; const float* W; bf16_t* Bt; int Nsrc, K, Np, mode;
        if (t < T0) { W = F.f1w13; Bt = F.W13A; Nsrc = 2 * DFF; K = D; Np = 2 * DFF; mode = 1; }
        else if ((t -= T0) < T1) { W = F.f1w2; Bt = F.W2A; Nsrc = D; K = DFF; Np = D; mode = 0; }
        else if ((t -= T1) < T2) { W = F.w_in; Bt = F.WIN; Nsrc = 12320; K = D; Np = NINP; mode = 2; }
        else if ((t -= T2) < T3) { W = F.w_m; Bt = F.WM; Nsrc = D; K = DV; Np = D; mode = 0; }
        else if ((t -= T3) < T4) { W = F.w_c; Bt = F.WC; Nsrc = D; K = DCONV; Np = D; mode = 0; }
        else if ((t -= T4) < T5) { W = F.w_o; Bt = F.WO; Nsrc = D; K = D; Np = D; mode = 0; }
        else if ((t -= T5) < T6) { W = F.f2w13; Bt = F.W13B; Nsrc = 2 * DFF; K = D; Np = 2 * DFF; mode = 1; }
        else { t -= T6; W = F.f2w2; Bt = F.W2B; Nsrc = D; K = DFF; Np = D; mode = 0; }
        const int ntn = Np / 256, tn = t % ntn, tk = t / ntn;
        cvt_tile(W, Nsrc, Bt, (Bt == F.WC) ? D : K, tk * 64, tn * 256, mode);
    }
}

__device__ __forceinline__ void store_modin(const f32x4 (&y)[8], const float* modr, int sub, bf16_t* arow, int lane) {
    const float* shift = modr + (sub * 3 + 0) * D; const float* scale = modr + (sub * 3 + 1) * D;
#pragma unroll
    for (int i = 0; i < 8; ++i) { const int idx = (i * 64 + lane) * 4; const f32x4 s = *(const f32x4*)(scale + idx), sh = *(const f32x4*)(shift + idx);
        const f32x4 o = y[i] * (s + 1.f) + sh; u32x2 w; w.x = pk2(o[0], o[1]); w.y = pk2(o[2], o[3]); *(u32x2*)(arow + idx) = w; }
}
__device__ __forceinline__ void p_modin0(const Frame& F) {
    const int lane = threadIdx.x & 63, wv = threadIdx.x >> 6;
    for (int row = blockIdx.x * NWAVES + wv; row < MT; row += gridDim.x * NWAVES) {
        const float* src = row < MX ? F.x + (size_t)row * D : F.ctx + (size_t)(row - MX) * D;
        const int r = row < MX ? row >> 12 : 2;
        f32x4 y[8];
#pragma unroll
        for (int i = 0; i < 8; ++i) y[i] = *(const f32x4*)(src + (i * 64 + lane) * 4);
        store_modin(y, F.mod + r * 9 * D, 0, F.ACTA + (size_t)row * D, lane);
    }
}
template <int SUB> __device__ __forceinline__ void p_residual(const Frame& F, float weight, int nrows, const float* PART) {
    const int lane = threadIdx.x & 63, wv = threadIdx.x >> 6;
    for (int row = blockIdx.x * NWAVES + wv; row < nrows; row += gridDim.x * NWAVES) {
        const bool isx = row < MX;
        const float* xin = isx ? ((SUB == 0 ? F.x : (const float*)F.out) + (size_t)row * D) : F.ctx + (size_t)(row - MX) * D;
        const int r = isx ? row >> 12 : 2;
        const float* modr = F.mod + r * 9 * D; const float* gate = modr + (SUB * 3 + 2) * D;
        const float* orow = F.OBUF + (size_t)row * D; const float* lg = F.pg + SUB * D; const float* lb = F.pb + SUB * D;
        f32x4 v[8]; float s = 0.f;
#pragma unroll
        for (int i = 0; i < 8; ++i) { const int idx = (i * 64 + lane) * 4; const f32x4 xv = *(const f32x4*)(xin + idx), gv = *(const f32x4*)(gate + idx); f32x4 ov;
            if (isx) ov = *(const f32x4*)(orow + idx);
            else { ov = (f32x4){0.f, 0.f, 0.f, 0.f};
#pragma unroll
                for (int p = 0; p < CTX_KSPLIT; ++p) ov += *(const f32x4*)(PART + ((size_t)p * MC + (row - MX)) * D + idx); }
            v[i] = xv * ALPHA + (gv * weight) * ov; s += (v[i][0] + v[i][1]) + (v[i][2] + v[i][3]); }
        const float mean = wsum(s) * (1.f / D); float q = 0.f;
#pragma unroll
        for (int i = 0; i < 8; ++i) { v[i] = v[i] - mean; q += (v[i][0] * v[i][0] + v[i][1] * v[i][1]) + (v[i][2] * v[i][2] + v[i][3] * v[i][3]); }
        const float rstd = rsqrtf(wsum(q) * (1.f / D) + LN_EPS);
#pragma unroll
        for (int i = 0; i < 8; ++i) { const int idx = (i * 64 + lane) * 4; v[i] = v[i] * rstd * *(const f32x4*)(lg + idx) + *(const f32x4*)(lb + idx);
            if (isx) *(f32x4*)(F.out + (size_t)row * D + idx) = v[i]; }
        if (SUB < 2) store_modin(v, modr, SUB + 1, F.ACTA + (size_t)row * D, lane);
    }
}
__device__ __forceinline__ void p_headnorm(const Frame& F, const float* HF0, const float* HF1, bf16_t* AM) {
    const int lane = threadIdx.x & 63, wv = threadIdx.x >> 6;
    for (int row = blockIdx.x * NWAVES + wv; row < MX; row += gridDim.x * NWAVES) {
#pragma unroll
        for (int hh = 0; hh < NH; ++hh) {
            const size_t o = (size_t)row * DV + hh * 256 + lane * 4;
            f32x4 v = *(const f32x4*)(HF0 + o) + *(const f32x4*)(HF1 + o);
            const float mean = wsum((v[0] + v[1]) + (v[2] + v[3])) * (1.f / 256.f);
            v = v - mean;
            const float rstd = rsqrtf(wsum((v[0] * v[0] + v[1] * v[1]) + (v[2] * v[2] + v[3] * v[3])) * (1.f / 256.f) + LN_EPS);
            const f32x4 g = *(const f32x4*)(F.mh_g + hh * 256 + lane * 4); const u32x2 so = *(const u32x2*)(F.OB + o);
            v = v * rstd * g;
            u32x2 w; w.x = pk2(v[0] * bflo(so.x), v[1] * bfhi(so.x)); w.y = pk2(v[2] * bflo(so.y), v[3] * bfhi(so.y));
            *(u32x2*)(AM + o) = w;
        }
    }
}

constexpr int LP = 136;
constexpr int L_Q = 0, L_K = 34816, L_KT = 69632, L_VT = 104448, L_CT = 117504, L_ARR = 130560;
__device__ __forceinline__ float logsig(float x) { return fminf(x, 0.f) - log1pf(expf(-fabsf(x))); }
__device__ __forceinline__ int chunk_row0(int cc, int dir, int b) { if (cc < 2) { const int ci = dir ? 1 - cc : cc; return MX + b * CTXL + ci * 128; } const int xi = dir ? 33 - cc : cc - 2; return b * SEQ + xi * 128; }
__device__ __forceinline__ unsigned short hsel(const u32x4& v, int i) { const unsigned w = (i >> 1) == 0 ? v.x : (i >> 1) == 1 ? v.y : (i >> 1) == 2 ? v.z : v.w; return (unsigned short)((i & 1) ? (w >> 16) : (w & 0xffffu)); }

__device__ __forceinline__ float ml_scan(const float (&gi)[2], const float (&gf)[2], float m_run, int lane, LAS float* cU) {
    LAS float* cM = cU + 128; LAS float* cB = cU + 256; LAS float* cW = cU + 384; LAS float* cS = cU + 512;
    const float lf0 = logsig(gf[0]), lf1 = logsig(gf[1]), p = lf0 + lf1; float incl = p;
#pragma unroll
    for (int o = 1; o < 64; o <<= 1) { const float t = __shfl_up(incl, o); if (lane >= o) incl += t; }
    const float b0 = incl - p + lf0, b1 = incl, u0 = gi[0] - b0, u1 = gi[1] - b1;
    float im = fmaxf(u0, u1);
#pragma unroll
    for (int o = 1; o < 64; o <<= 1) { const float t = __shfl_up(im, o); if (lane >= o) im = fmaxf(im, t); }
    float ex = __shfl_up(im, 1); if (lane == 0) ex = -INFINITY;
    const float pm0 = fmaxf(ex, u0), pm1 = fmaxf(pm0, u1);
    const float g = __shfl(b1, 63), pml = __shfl(pm1, 63);
    const float Ml = fmaxf(m_run, pml);
    *(LAS f32x2v*)(cU + 2 * lane) = (f32x2v){u0, u1}; *(LAS f32x2v*)(cM + 2 * lane) = (f32x2v){fmaxf(m_run, pm0), fmaxf(m_run, pm1)};
    *(LAS f32x2v*)(cB + 2 * lane) = (f32x2v){b0, b1}; *(LAS f32x2v*)(cW + 2 * lane) = (f32x2v){__expf(u0 - Ml), __expf(u1 - Ml)};
    if (lane == 0) { cS[0] = __expf(m_run - Ml); cS[1] = m_run; }
    return g + Ml;
}
__device__ __forceinline__ void mlstm_unit(const Frame& F, int unit, LAS unsigned char* lds, float* HF0, float* HF1) {
    const int tid = threadIdx.x, lane = tid & 63, w = __builtin_amdgcn_readfirstlane(tid >> 6), l15 = lane & 15, q = lane >> 4;
    const int dir = unit >> 7, b = (unit >> 6) & 1, h = (unit >> 3) & 7, sl = unit & 7;
    LAS bf16_t* sQ = (LAS bf16_t*)(lds + L_Q); LAS bf16_t* sK = (LAS bf16_t*)(lds + L_K); LAS bf16_t* sKt = (LAS bf16_t*)(lds + L_KT);
    LAS bf16_t* sVt = (LAS bf16_t*)(lds + L_VT); LAS bf16_t* sCt = (LAS bf16_t*)(lds + L_CT);
    LAS float* sU = (LAS float*)(lds + L_ARR);
    float* HF = dir ? HF1 : HF0;
    for (int i = tid; i < 16 * LP; i += NTHREADS) sVt[32 * LP + i] = (i < LP) ? (bf16_t)0x3F80 : (bf16_t)0;
    for (int i = tid; i < 48 * LP; i += NTHREADS) sCt[i] = 0;
    f32x4 accC[3];
#pragma unroll
    for (int nt = 0; nt < 3; ++nt) accC[nt] = (f32x4){0.f, 0.f, 0.f, 0.f};
    float m_run = -1e4f;
    const int rg = tid >> 4, cgp = tid & 15;
    u32x4 kreg[4], qreg[4]; unsigned vreg[4]; float gi[2], gf[2];
    const int kcol = h * 128 + 8 * cgp, vcol = h * 256 + sl * 32 + 2 * cgp, gcol = dir * 16 + h;
#pragma unroll
    for (int r = 0; r < 4; ++r) qreg[r] = (u32x4){0u, 0u, 0u, 0u};
    gi[0] = gi[1] = gf[0] = gf[1] = 0.f;
#define ML_LOAD(cc) do { const int _r0 = chunk_row0((cc), dir, b); \
        _Pragma("unroll") for (int r = 0; r < 4; ++r) { const int j = 4 * rg + r; const size_t row = (size_t)(_r0 + (dir ? 127 - j : j)); \
            kreg[r] = *(const u32x4*)(F.KB + row * DQK + kcol); if ((cc) >= 2) qreg[r] = *(const u32x4*)(F.QB + row * DQK + kcol); vreg[r] = *(const unsigned*)(F.VB + row * DV + vcol); } } while (0)
#define ML_LOADG(cc) do { const int _r0 = chunk_row0((cc), dir, b); \
        _Pragma("unroll") for (int e = 0; e < 2; ++e) { const int j = 2 * lane + e; const size_t row = (size_t)(_r0 + (dir ? 127 - j : j)); gi[e] = F.GATES[row * 32 + gcol]; gf[e] = F.GATES[row * 32 + gcol + 8]; } } while (0)
    ML_LOAD(0);
    if (w == 0) { ML_LOADG(0); m_run = ml_scan(gi, gf, m_run, lane, sU); ML_LOADG(1); }
    for (int cc = 0; cc < 34; ++cc) {
        const bool isx = cc >= 2;
        const int row0 = chunk_row0(cc, dir, b);
#pragma unroll
        for (int r = 0; r < 4; ++r) { *(LAS u32x4*)(sK + (4 * rg + r) * LP + 8 * cgp) = kreg[r]; if (isx) *(LAS u32x4*)(sQ + (4 * rg + r) * LP + 8 * cgp) = qreg[r]; }
#pragma unroll
        for (int i = 0; i < 8; ++i) { const int d = 8 * cgp + i; u32x2 wv; wv.x = (unsigned)hsel(kreg[0], i) | ((unsigned)hsel(kreg[1], i) << 16); wv.y = (unsigned)hsel(kreg[2], i) | ((unsigned)hsel(kreg[3], i) << 16);
            *(LAS u32x2*)(sKt + d * LP + 8 * ((rg >> 1) ^ (cgp & 7)) + 4 * (rg & 1)) = wv; }
#pragma unroll
        for (int i = 0; i < 2; ++i) { const int e = 2 * cgp + i; u32x2 wv;
            wv.x = (i ? (vreg[0] >> 16) : (vreg[0] & 0xffffu)) | ((i ? (vreg[1] >> 16) : (vreg[1] & 0xffffu)) << 16);
            wv.y = (i ? (vreg[2] >> 16) : (vreg[2] & 0xffffu)) | ((i ? (vreg[3] >> 16) : (vreg[3] & 0xffffu)) << 16);
            *(LAS u32x2*)(sVt + e * LP + 4 * rg) = wv; }
        if (cc + 1 < 34) ML_LOAD(cc + 1);
        __syncthreads();
        if (w == 0 && cc + 1 < 34) { m_run = ml_scan(gi, gf, m_run, lane, sU + ((cc + 1) & 1) * 528); if (cc + 2 < 34) ML_LOADG(cc + 2); }
        LAS float* cU = sU + (cc & 1) * 528; LAS float* cM = cU + 128; LAS float* cB = cU + 256; LAS float* cW = cU + 384; LAS float* cS = cU + 512;
        if (isx) {
            bf16x8 qf[4];
#pragma unroll
            for (int ks = 0; ks < 4; ++ks) qf[ks] = *(const LAS bf16x8*)(sQ + (16 * w + l15) * LP + 32 * ks + 8 * q);
            f32x4 accO[3];
#pragma unroll
            for (int nt = 0; nt < 3; ++nt) accO[nt] = (f32x4){0.f, 0.f, 0.f, 0.f};
#pragma unroll
            for (int ks = 0; ks < 4; ++ks)
#pragma unroll
                for (int nt = 0; nt < 3; ++nt) { const bf16x8 bfr = *(const LAS bf16x8*)(sCt + (16 * nt + l15) * LP + 32 * ks + 8 * q); accO[nt] = __builtin_amdgcn_mfma_f32_16x16x32_bf16(qf[ks], bfr, accO[nt], 0, 0, 0); }
            const float m_old = cS[1];
#pragma unroll
            for (int i = 0; i < 4; ++i) { const float wi = __expf(m_old - cM[16 * w + 4 * q + i]);
#pragma unroll
                for (int nt = 0; nt < 3; ++nt) accO[nt][i] *= wi; }
            const float Mj = cM[16 * w + l15];
            for (int mt = 0; mt <= w; ++mt) {
                f32x4 s = (f32x4){0.f, 0.f, 0.f, 0.f};
#pragma unroll
                for (int ks = 0; ks < 4; ++ks) { const bf16x8 a = *(const LAS bf16x8*)(sK + (16 * mt + l15) * LP + 32 * ks + 8 * q); s = __builtin_amdgcn_mfma_f32_16x16x32_bf16(a, qf[ks], s, 0, 0, 0); }
                const f32x4 uu = *(const LAS f32x4*)(cU + 16 * mt + 4 * q);
                float pv[4];
#pragma unroll
                for (int i = 0; i < 4; ++i) { const float e = s[i] * __expf(uu[i] - Mj); pv[i] = (mt == w && (4 * q + i) > l15) ? 0.f : e; }
                u32x2 wv; wv.x = pk2(pv[0], pv[1]); wv.y = pk2(pv[2], pv[3]);
                *(LAS u32x2*)(sQ + (16 * w + l15) * LP + 16 * mt + 4 * q) = wv;
            }
            if (!(w & 1)) { u32x2 z; z.x = 0u; z.y = 0u; *(LAS u32x2*)(sQ + (16 * w + l15) * LP + 16 * (w + 1) + 4 * q) = z; }
            const int nks = (w >> 1) + 1;
            for (int ks = 0; ks < nks; ++ks) {
                const bf16x8 a = *(const LAS bf16x8*)(sQ + (16 * w + l15) * LP + 32 * ks + 8 * q);
#pragma unroll
                for (int nt = 0; nt < 3; ++nt) { const bf16x8 bfr = *(const LAS bf16x8*)(sVt + (16 * nt + l15) * LP + 32 * ks + 8 * q); accO[nt] = __builtin_amdgcn_mfma_f32_16x16x32_bf16(a, bfr, accO[nt], 0, 0, 0); }
            }
#pragma unroll
            for (int i = 0; i < 4; ++i) {
                const int j = 16 * w + 4 * q + i;
                const float den = __shfl(accO[2][i], lane & 48);
                const float dd = fmaxf(fabsf(den), __expf(-(cB[j] + cM[j]))), inv = 1.f / dd;
                float* hp = HF + (size_t)(row0 + (dir ? 127 - j : j)) * DV + h * 256 + sl * 32 + l15;
                hp[0] = accO[0][i] * inv; hp[16] = accO[1][i] * inv;
            }
        }
        {
            const float decay = cS[0];
#pragma unroll
            for (int nt = 0; nt < 3; ++nt) accC[nt] = accC[nt] * decay;
            const int d = 16 * w + l15;
#pragma unroll
            for (int ks = 0; ks < 4; ++ks) {
                const u32x4 kv = *(const LAS u32x4*)(sKt + d * LP + 8 * ((4 * ks + q) ^ ((d >> 3) & 7)));
                const f32x4 w0 = *(const LAS f32x4*)(cW + 32 * ks + 8 * q), w1 = *(const LAS f32x4*)(cW + 32 * ks + 8 * q + 4);
                u32x4 av; av.x = pk2(bflo(kv.x) * w0[0], bfhi(kv.x) * w0[1]); av.y = pk2(bflo(kv.y) * w0[2], bfhi(kv.y) * w0[3]);
                av.z = pk2(bflo(kv.z) * w1[0], bfhi(kv.z) * w1[1]); av.w = pk2(bflo(kv.w) * w1[2], bfhi(kv.w) * w1[3]);
                const bf16x8 a = __builtin_bit_cast(bf16x8, av);
#pragma unroll
                for (int nt = 0; nt < 3; ++nt) { const bf16x8 bfr = *(const LAS bf16x8*)(sVt + (16 * nt + l15) * LP + 32 * ks + 8 * q); accC[nt] = __builtin_amdgcn_mfma_f32_16x16x32_bf16(a, bfr, accC[nt], 0, 0, 0); }
            }
        }
        __syncthreads();
#pragma unroll
        for (int nt = 0; nt < 3; ++nt) { u32x2 wv; wv.x = pk2(accC[nt][0], accC[nt][1]); wv.y = pk2(accC[nt][2], accC[nt][3]); *(LAS u32x2*)(sCt + (16 * nt + l15) * LP + 16 * w + 4 * q) = wv; }
    }
#undef ML_LOAD
#undef ML_LOADG
    __syncthreads();
}

__device__ __forceinline__ void conv_unit(const Frame& F, int unit, LAS unsigned char* lds) {
    const int tid = threadIdx.x, lane = tid & 63, wv = tid >> 6, c0 = 2 * tid;
    const int b = unit >> 7, r = (unit >> 1) & 63, half = unit & 1;
    const bf16_t* U = F.UB + (size_t)(b * SEQ) * DCONV + c0;
    float y0[32], y1[32];
#pragma unroll
    for (int j = 0; j < 32; ++j) { y0[j] = 0.f; y1[j] = 0.f; }
    if (tid < 256) {
        float w0[31], w1[31];
#pragma unroll
        for (int k = 0; k < 31; ++k) { const f32x2v ww = *(const f32x2v*)(F.conv_w + k * DCONV + c0); w0[k] = ww.x; w1[k] = ww.y; }
#pragma unroll
        for (int i = 0; i < 62; ++i) {
            const int col = half * 32 - 15 + i; float u0 = 0.f, u1 = 0.f;
            if (col >= 0 && col < 64) { const unsigned v = *(const unsigned*)(U + (size_t)(r * 64 + col) * DCONV); u0 = bflo(v); u1 = bfhi(v); }
#pragma unroll
            for (int j = 0; j < 32; ++j) { const int k = i - j; if (k >= 0 && k <= 30) { y0[j] += w0[k] * u0; y1[j] += w1[k] * u1; } }
        }
    } else {
        for (int k = 0; k < 31; ++k) {
            const int rr = r + k - 15; if (rr < 0 || rr >= 64) continue;
            const f32x2v ww = *(const f32x2v*)(F.conv_w + k * DCONV + c0);
            const bf16_t* up = U + (size_t)(rr * 64 + half * 32) * DCONV;
#pragma unroll
            for (int j = 0; j < 32; ++j) { const unsigned v = *(const unsigned*)(up + (size_t)j * DCONV); y0[j] += ww.x * bflo(v); y1[j] += ww.y * bfhi(v); }
        }
    }
    const f32x2v cb = *(const f32x2v*)(F.conv_b + c0);
    LAS float* red = (LAS float*)lds;
    LAS float* stat = red + 512;
#pragma unroll
    for (int j = 0; j < 32; ++j) {
        y0[j] += cb.x; y1[j] += cb.y;
        const float s1 = wsum(y0[j] + y1[j]), s2 = wsum(y0[j] * y0[j] + y1[j] * y1[j]);
        if (lane == 0) { red[wv * 64 + j] = s1; red[wv * 64 + 32 + j] = s2; }
    }
    __syncthreads();
    if (tid < 32) { float a = 0.f, q = 0.f;
#pragma unroll
        for (int g = 0; g < 8; ++g) { a += red[g * 64 + tid]; q += red[g * 64 + 32 + tid]; }
        const float mean = a * (1.f / DCONV), var = fmaxf(q * (1.f / DCONV) - mean * mean, 0.f);
        stat[2 * tid] = mean; stat[2 * tid + 1] = rsqrtf(var + LN_EPS); }
    __syncthreads();
    const f32x2v lg = *(const f32x2v*)(F.conv_g + c0), lb = *(const f32x2v*)(F.conv_bb + c0);
    bf16_t* ap = F.AC + (size_t)(b * SEQ + r * 64 + half * 32) * D + c0;
#pragma unroll
    for (int j = 0; j < 32; ++j) {
        const float mean = stat[2 * j], rstd = stat[2 * j + 1];
        const float a0 = (y0[j] - mean) * rstd * lg.x + lb.x, a1 = (y1[j] - mean) * rstd * lg.y + lb.y;
        *(unsigned*)(ap + (size_t)j * D) = pk2(a0 * sigm(a0), a1 * sigm(a1));
    }
    __syncthreads();
}

typedef unsigned v4u_unused __attribute__((ext_vector_type(4)));
#define XB_TMO      128
#define XB_XCNT(j)  (256  + 64 * (j))
#define XB_XSUB(j)  (1280 + 64 * (j))
#define XB_XGEN(j)  (2304 + 64 * (j))
#define XB_TOP      3328
#define XB_TOPGEN   3392
#define XCD_BAR_WORDS 3456
#define XB_SPIN_CAP (1u << 18)

__device__ __forceinline__ unsigned xb_ld(unsigned* p)              { return __hip_atomic_load(p, __ATOMIC_RELAXED, __HIP_MEMORY_SCOPE_AGENT); }
__device__ __forceinline__ unsigned xb_add(unsigned* p, unsigned v) { return __hip_atomic_fetch_add(p, v, __ATOMIC_RELAXED, __HIP_MEMORY_SCOPE_AGENT); }
__device__ __forceinline__ unsigned xb_xcc_id() { return (unsigned)__builtin_amdgcn_s_getreg((3 << 11) | 20) & 0xFu; }
#define XB_SPIN(cond, bar) do { unsigned _sp = 0; while (cond) { __builtin_amdgcn_s_sleep(1); \
    if ((++_sp & 255u) == 0u) { if (xb_ld(&(bar)[XB_TMO])) break; if (_sp > XB_SPIN_CAP) { atomicAdd(&(bar)[XB_TMO], 1u); break; } } } } while (0)

struct XcdBarrier {
    unsigned* bar; unsigned x;
    volatile LAS unsigned* st;
};

__device__ __forceinline__ XcdBarrier xcd_barrier_post(unsigned* bar, volatile LAS unsigned* st) {
    XcdBarrier b; b.bar = bar; b.x = xb_xcc_id(); b.st = st;
    if (threadIdx.x == 0) (void)xb_add(&bar[XB_XCNT(b.x)], 1u);
    return b;
}
__device__ __forceinline__ void xcd_barrier_complete(unsigned* bar, unsigned x, unsigned& nloc, unsigned& nx) {
    const unsigned G = gridDim.x * gridDim.y * gridDim.z;
    unsigned sum, cnt, mine, sp = 0u;
    for (;;) {
        sum = 0u; cnt = 0u; mine = 0u;
#pragma unroll
        for (unsigned j = 0; j < 16; ++j) { const unsigned c = xb_ld(&bar[XB_XCNT(j)]); sum += c; cnt += (c > 0u) ? 1u : 0u; mine = (j == x) ? c : mine; }
        if (sum == G) break;
        __builtin_amdgcn_s_sleep(1);
        if ((++sp & 255u) == 0u) { if (xb_ld(&bar[XB_TMO])) break; if (sp > XB_SPIN_CAP) { atomicAdd(&bar[XB_TMO], 1u); break; } }
    }
    nloc = mine > 0u ? mine : 1u; nx = cnt > 0u ? cnt : 1u;
}

__device__ __forceinline__ void xcd_barrier(const XcdBarrier& b) {
    asm volatile("s_waitcnt vmcnt(0)" ::: "memory");
    __syncthreads();
    if (threadIdx.x == 0) {
        unsigned* bar = b.bar;
        __builtin_amdgcn_s_waitcnt(0);
        unsigned nloc = b.st[0], nx = b.st[1];
        if (nloc == 0u) { xcd_barrier_complete(bar, b.x, nloc, nx); b.st[0] = nloc; b.st[1] = nx; }
        const unsigned old = xb_add(&bar[XB_XSUB(b.x)], 1u);
        const unsigned gen = old / nloc;
        if (old + 1u == (gen + 1u) * nloc) {
            __builtin_amdgcn_fence(__ATOMIC_RELEASE, "agent");
            asm volatile("s_waitcnt vmcnt(0)" ::: "memory");
            const unsigned og = xb_add(&bar[XB_TOP], 1u);
            const unsigned tg = og / nx;
            if (og + 1u == (tg + 1u) * nx) xb_add(&bar[XB_TOPGEN], 1u);
            else XB_SPIN(xb_ld(&bar[XB_TOPGEN]) == tg, bar);
            __builtin_amdgcn_fence(__ATOMIC_ACQUIRE, "agent");
            xb_add(&bar[XB_XGEN(b.x)], 1u);
            asm volatile("s_waitcnt vmcnt(0)" ::: "memory");
        } else {
            XB_SPIN(xb_ld(&bar[XB_XGEN(b.x)]) == gen, bar);
            __builtin_amdgcn_fence(__ATOMIC_ACQUIRE, "agent");
            asm volatile("s_waitcnt vmcnt(0)" ::: "memory");
        }
    }
    __syncthreads();
}


#ifndef PROBE_P3
#define PROBE_P3 1
#endif
#ifndef PROBE_P89
#define PROBE_P89 1
#endif
#ifndef PROBE_ROWS
#define PROBE_ROWS 1
#endif
struct Args { const float* in[22]; float* out; unsigned char* ws; int ph_lo, ph_hi; };
constexpr int N_PHASES = 14;

__global__ void __launch_bounds__(NTHREADS, 2) hybrid_fwd(Args args) {
    extern __shared__ __attribute__((aligned(16))) unsigned char lds_raw[];
    LAS unsigned char* lds = (LAS unsigned char*)lds_raw;
    cg::grid_group grid = cg::this_grid();
    Frame F;
    F.x = args.in[0]; F.c = args.in[1]; F.ctx = args.in[2]; F.c_ctx = args.in[3]; F.w_ada = args.in[4]; F.b_ada = args.in[5]; F.w_in = args.in[6]; F.b_in = args.in[7];
    F.mh_g = args.in[8]; F.conv_w = args.in[9]; F.conv_b = args.in[10]; F.conv_g = args.in[11]; F.conv_bb = args.in[12]; F.w_m = args.in[13]; F.w_c = args.in[14]; F.w_o = args.in[15];
    F.f1w13 = args.in[16]; F.f1w2 = args.in[17]; F.f2w13 = args.in[18]; F.f2w2 = args.in[19]; F.pg = args.in[20]; F.pb = args.in[21];
    F.out = args.out; unsigned char* ws = args.ws; F.ws = ws;
    F.mod = (float*)(ws + WS_MOD); F.bperm = (float*)(ws + WS_BPERM); F.OBUF = (float*)(ws + WS_OBUF); F.GATES = (float*)(ws + WS_GATES);
    F.W13A = (bf16_t*)(ws + WS_W13A); F.W2A = (bf16_t*)(ws + WS_W2A); F.WIN = (bf16_t*)(ws + WS_WIN); F.WM = (bf16_t*)(ws + WS_WM); F.WC = (bf16_t*)(ws + WS_AC);     F.WO = (bf16_t*)(ws + WS_WO);
    F.W13B = (bf16_t*)(ws + WS_W13B); F.W2B = (bf16_t*)(ws + WS_W2B); F.ACTA = (bf16_t*)(ws + WS_ACTA); F.HBUF = (bf16_t*)(ws + WS_HBUF);
    F.KB = (bf16_t*)(ws + WS_KB); F.VB = (bf16_t*)(ws + WS_VB); F.QB = (bf16_t*)(ws + WS_QB); F.OB = (bf16_t*)(ws + WS_OB); F.UB = (bf16_t*)(ws + WS_UB);
    F.GM = (bf16_t*)(ws + WS_GM); F.GC = (bf16_t*)(ws + WS_GC); F.AC = (bf16_t*)(ws + WS_ACTA);
    float* PART = (float*)(ws + WS_OBUF) + (size_t)MX * D; float* HF0 = (float*)(ws + WS_HBUF); float* HF1 = (float*)(ws + WS_OBUF); bf16_t* AM = (bf16_t*)(ws + WS_KB); bf16_t* MB = (bf16_t*)(ws + WS_QB);
    const int lo = args.ph_lo, hi = args.ph_hi, G = gridDim.x, bx = blockIdx.x;
#define IN(k) (lo <= (k) && (k) < hi)
#ifndef PROBE_SYNC
#define PROBE_SYNC 1
#endif
    XcdBarrier xbar; xbar.bar = (unsigned*)(ws + WS_BAR); xbar.x = 0; xbar.st = (volatile LAS unsigned*)(lds + LDS_BYTES - 64);
    if (threadIdx.x < 2) xbar.st[threadIdx.x] = 0u;
    __syncthreads();
    xbar = xcd_barrier_post((unsigned*)(ws + WS_BAR), (volatile LAS unsigned*)(lds + LDS_BYTES - 64));
#define SEAM(k) do { if (IN(k) && IN((k) + 1)) { for (int _s = 0; _s < PROBE_SYNC; ++_s) { if ((k) == 0 && lo < 0) grid.sync(); else xcd_barrier(xbar); } } } while (0)

#ifndef PROBE_P0
#define PROBE_P0 1
#endif
    if (IN(0)) { for (int rep = 0; rep < PROBE_P0; ++rep) p0_prep(F, lds); } SEAM(0);
    if (IN(1)) { for (int rep = 0; rep < PROBE_ROWS; ++rep) p_modin0(F); } SEAM(1);
    if (IN(2)) {
        pg8::Gemm g{F.ACTA, F.W13A, MT, 2 * DFF, D, D}; pg8::StaticOrder S; S.init(MT, 2 * DFF, G, bx); EpiSwiGLU E{F.HBUF};
#ifndef PROBE_P2
#define PROBE_P2 1
#endif
        for (int rep = 0; rep < PROBE_P2; ++rep) pg8::gemm_phase<EpiSwiGLU, pg8::StaticOrder, true, true>(lds, g, S, E); } SEAM(2);
    if (IN(3)) {
        pg8::Gemm g{F.HBUF, F.W2A, MT, D, DFF, DFF}; FfnDownOrder S; S.init(G, bx); EpiF32 E{F.OBUF};
        pg8::gemm_phase<EpiF32, FfnDownOrder, true, true>(lds, g, S, E); } SEAM(3);
#ifndef PROBE_P4
#define PROBE_P4 1
#endif
    if (IN(4)) { for (int rep = 0; rep < PROBE_P4; ++rep) p_residual<0>(F, 0.5f, MT, PART); } SEAM(4);
    if (IN(5)) {
        pg8::Gemm g{F.ACTA, F.WIN, MT, NINP, D, D}; InProjOrder S; S.init(G, bx);
        EpiInProj E{F.bperm, F.KB, F.VB, F.QB, F.OB, F.UB, F.GM, F.GC, F.GATES};
#ifndef PROBE_P5
#define PROBE_P5 1
#endif
        pg8::gemm_phase<EpiInProj, InProjOrder, true, true>(lds, g, S, E); } SEAM(5);
    if (IN(6)) {
#ifndef PROBE_MLSTM
#define PROBE_MLSTM 1
#endif
#ifndef PROBE_CONV
#define PROBE_CONV 1
#endif
        for (int rep = 0; rep < PROBE_MLSTM; ++rep) for (int u = bx; u < 256; u += G) mlstm_unit(F, (u & 31) * 8 + (u >> 5), lds, HF0, HF1);
        for (int rep = 0; rep < PROBE_CONV; ++rep) for (int u = bx; u < 256; u += G) conv_unit(F, u, lds);
    } SEAM(6);
    if (IN(7)) { for (int rep = 0; rep < PROBE_ROWS; ++rep) p_headnorm(F, HF0, HF1, AM); } SEAM(7);
    if (IN(8)) {
        pg8::Gemm g{F.AC, F.WC, MX, D, DCONV, D, AM, F.WM}; MergeOrder S; S.init(G, bx); EpiMerge2 E{F.GC, F.GM, MB};
        pg8::gemm_phase<EpiMerge2, MergeOrder, true, true>(lds, g, S, E); } SEAM(8);
    if (IN(9)) {
        pg8::Gemm g{MB, F.WO, MX, D, D, D}; pg8::StaticOrder S; S.init(MX, D, G, bx); EpiF32 E{F.OBUF};
        pg8::gemm_phase<EpiF32, pg8::StaticOrder, true, true>(lds, g, S, E); } SEAM(9);
    if (IN(10)) { p_residual<1>(F, 1.0f, MX, PART); } SEAM(10);
    if (IN(11)) {
        pg8::Gemm g{F.ACTA, F.W13B, MX, 2 * DFF, D, D}; pg8::StaticOrder S; S.init(MX, 2 * DFF, G, bx); EpiSwiGLU E{F.HBUF};
#ifndef PROBE_P11
#define PROBE_P11 1
#endif
        for (int rep = 0; rep < PROBE_P11; ++rep) pg8::gemm_phase<EpiSwiGLU, pg8::StaticOrder, true, true>(lds, g, S, E); } SEAM(11);
    if (IN(12)) {
        pg8::Gemm g{F.HBUF, F.W2B, MX, D, DFF, DFF}; pg8::StaticOrder S; S.init(MX, D, G, bx); EpiF32 E{F.OBUF};
#ifndef PROBE_P12
#define PROBE_P12 1
#endif
        for (int rep = 0; rep < PROBE_P12; ++rep) pg8::gemm_phase<EpiF32, pg8::StaticOrder, true, true>(lds, g, S, E); } SEAM(12);
    if (IN(13)) { p_residual<2>(F, 0.5f, MX, PART); }
#ifdef PROBE_EXTRA
    if (IN(20)) { pg8::Gemm g{F.ACTA, F.W13B, MX, 2 * DFF, D, D}; pg8::StaticOrder S; S.init(MX, 2 * DFF, G, bx); EpiNull E{F.OBUF};
        pg8::gemm_phase<EpiNull, pg8::StaticOrder, true, true>(lds, g, S, E); }
    if (IN(21)) { pg8::Gemm g{F.ACTA, F.W13B, MX, 2 * DFF, D / 2, D}; pg8::StaticOrder S; S.init(MX, 2 * DFF, G, bx); EpiNull E{F.OBUF};
        pg8::gemm_phase<EpiNull, pg8::StaticOrder, true, true>(lds, g, S, E); }
#endif
#undef IN
#undef SEAM
}

#ifndef MK_ONE_LAUNCH
#define MK_ONE_LAUNCH 1
#endif
extern "C" void kernel_launch(void* const* d_in, const int* in_sizes, int n_in, void* d_out, int out_size, void* d_ws, size_t ws_size, hipStream_t stream) {
    static int grid = 0;
    if (grid == 0) {
        if (n_in != 22 || out_size != MX * D || ws_size < WS_END) { fprintf(stderr, "kernel_launch: unexpected shapes (n_in %d out %d ws %zu, need %zu)\n", n_in, out_size, ws_size, (size_t)WS_END); grid = -1; return; }
        int dev = 0, cus = 0, per_cu = 0;
        (void)hipGetDevice(&dev); (void)hipDeviceGetAttribute(&cus, hipDeviceAttributeMultiprocessorCount, dev);
        if (hipFuncSetAttribute((const void*)hybrid_fwd, hipFuncAttributeMaxDynamicSharedMemorySize, LDS_BYTES) != hipSuccess) { fprintf(stderr, "kernel_launch: hipFuncSetAttribute failed\n"); grid = -1; return; }
        if (hipOccupancyMaxActiveBlocksPerMultiprocessor(&per_cu, (const void*)hybrid_fwd, NTHREADS, LDS_BYTES) != hipSuccess || per_cu < 1) { fprintf(stderr, "kernel_launch: occupancy query says %d\n", per_cu); (void)hipGetLastError(); per_cu = 1; }
        grid = cus * per_cu; if (grid > 256) grid = 256;
    }
    if (grid < 0) return;
    Args a{};
    for (int i = 0; i < 22; ++i) a.in[i] = (const float*)d_in[i];
    a.out = (float*)d_out; a.ws = (unsigned char*)d_ws;
    if (hipMemsetAsync((char*)d_ws + WS_BAR, 0, XCD_BAR_WORDS * 4, stream) != hipSuccess) { fprintf(stderr, "kernel_launch: memset of the barrier words failed\n"); return; }
#if MK_ONE_LAUNCH
    a.ph_lo = 0; a.ph_hi = N_PHASES;
    void* kargs[] = {&a};
    const hipError_t e = hipLaunchCooperativeKernel((const void*)hybrid_fwd, dim3(grid), dim3(NTHREADS), kargs, (size_t)LDS_BYTES, stream);
    if (e != hipSuccess) fprintf(stderr, "kernel_launch: cooperative launch failed: %s (grid %d)\n", hipGetErrorString(e), grid);
#ifdef PROBE_EXTRA
    { const int ph[] = {PROBE_EXTRA}; for (int p : ph) { a.ph_lo = p; a.ph_hi = p + 1; hipLaunchKernelGGL(hybrid_fwd, dim3(grid), dim3(NTHREADS), LDS_BYTES, stream, a); } }
#endif
#else
    for (int p = 0; p < N_PHASES; ++p) { a.ph_lo = p; a.ph_hi = p + 1; hipLaunchKernelGGL(hybrid_fwd, dim3(grid), dim3(NTHREADS), LDS_BYTES, stream, a); }
#endif
}
```

```cpp
#include <hip/hip_runtime.h>
#include <hip/hip_cooperative_groups.h>
#include <cstdio>
#include <cstdint>
namespace cg = cooperative_groups;
namespace pg8 {
#define PG8_LAS __attribute__((address_space(3)))
typedef unsigned short bf16_t;
typedef short bf16x8 __attribute__((ext_vector_type(8)));
typedef float f32x4 __attribute__((ext_vector_type(4)));
typedef unsigned u32x4 __attribute__((ext_vector_type(4)));
constexpr int BM = 256, BK = 64, HALF = 128, HTB = HALF * BK * 2  , STAGE_BYTES = 8 * HTB, NXCD = 8, WGM = 8;

__host__ __device__ __forceinline__ int lds_byte(int r, int c) { const int st = (r >> 4) * 2 + (c >> 5), rr = r & 15, cc = c & 31, ob = rr * 64 + cc * 2; return st * 1024 + (ob ^ (((ob >> 9) & 1) << 5)); }
__host__ __device__ __forceinline__ void stage_rc(int b, int& R, int& C) { const int st = b / 1024, sb = b % 1024, swz = sb ^ (((sb >> 9) & 1) << 5); R = (st >> 1) * 16 + swz / 64; C = (st & 1) * 32 + (swz % 64) / 2; }
__host__ __device__ __forceinline__ int perm32(int rho) { const int n = rho >> 4, i = rho & 15; return 8 * (i >> 2) + 4 * n + (i & 3); }

struct Unit { int pm, pn, kp, nt, g, keep, orow; };
struct Gemm { const bf16_t* A; const bf16_t* Bt; int M, N, K, ld; const bf16_t* A1; const bf16_t* Bt1; };

struct StaticOrder {
    int nM, nN, nwg, G, c;
    __host__ __device__ void init(int M, int N, int G_, int c_) { nM = M / BM; nN = N / BM; nwg = nM * nN; G = G_; c = c_; }
    __host__ __device__ bool next(int i, Unit& u) const {
        const long L = (long)i * G + c; if (L >= nwg) return false;
        int wgid = (int)L; { const int q = nwg / NXCD, r = nwg % NXCD, xcd = wgid % NXCD, off = wgid / NXCD; wgid = (xcd < r ? xcd * (q + 1) : r * (q + 1) + (xcd - r) * q) + off; }
        const int nig = WGM * nN, gid = wgid / nig, fm = gid * WGM, gsz = (nM - fm) < WGM ? (nM - fm) : WGM;
        u.pm = fm + ((wgid % nig) % gsz); u.pn = (wgid % nig) / gsz; u.kp = 0; u.nt = 0; u.g = 0; u.keep = 0; u.orow = u.pm * BM; return true;
    }
    __device__ __forceinline__ void a_ready(const Unit&) const {}
    __device__ __forceinline__ void done(const Unit&) const {}
};
__device__ __forceinline__ unsigned cvt_pk_bf16(float lo, float hi) { unsigned r; asm volatile("v_cvt_pk_bf16_f32 %0, %1, %2" : "=v"(r) : "v"(lo), "v"(hi)); return r; }
typedef float f32x2 __attribute__((ext_vector_type(2)));
template <class Epi, class Sched, bool ALIGN_EPI = false, bool SP2 = false>
__device__ __forceinline__ void gemm_phase(PG8_LAS unsigned char* lds, const Gemm g, const Sched& S, const Epi& E) {
    const int tid = threadIdx.x, wid = __builtin_amdgcn_readfirstlane(tid >> 6), lane = tid & 63, wr = wid >> 2, wc = wid & 3, fr = lane & 15, fq = lane >> 4;
    const int K = g.K, nt = K / BK;
    unsigned voffA[2], voffB[2];
#pragma unroll
    for (int i = 0; i < 2; ++i) { int R, C; stage_rc(tid * 16 + i * 8192, R, C); const int Rb = Epi::PERM ? ((R & ~31) + perm32(R & 31)) : R;
        voffA[i] = (unsigned)(R * g.ld + C) * 2u; voffB[i] = (unsigned)(Rb * g.ld + C) * 2u; }
    const size_t kstep = (size_t)(BK * 2);
    const size_t hstep = (size_t)HALF * g.ld * 2;
    const size_t tstep = 2 * hstep;
    const unsigned ldsw = (unsigned)wid * 1024u;
    const int aoff = lds_byte(wr * 64 + fr, fq * 8), boff = lds_byte(wc * 32 + fr, fq * 8);
#define PG8_SA(b, h) (((b) * 2 + (h)) * HTB)
#define PG8_SB(b, h) ((4 + (b) * 2 + (h)) * HTB)
#define PG8_STAGE(bufoff, gbase, voff) do { _Pragma("unroll") for (int _i = 0; _i < 2; ++_i) \
        __builtin_amdgcn_global_load_lds((const unsigned*)((const char*)(gbase) + (voff)[_i]), (PG8_LAS unsigned*)(lds + (bufoff) + ldsw + _i * 8192), 16, 0, 0); } while (0)
#define PG8_LDA(dst, b, h) do { _Pragma("unroll") for (int m = 0; m < 4; ++m) _Pragma("unroll") for (int k = 0; k < 2; ++k) dst[m][k] = *(const PG8_LAS bf16x8*)(lds + PG8_SA(b, h) + aoff + m * 2048 + k * 1024); } while (0)
#define PG8_LDB(dst, b, h) do { _Pragma("unroll") for (int n = 0; n < 2; ++n) _Pragma("unroll") for (int k = 0; k < 2; ++k) dst[n][k] = *(const PG8_LAS bf16x8*)(lds + PG8_SB(b, h) + boff + n * 2048 + k * 1024); } while (0)
#define PG8_MMA(ai, bj, At, Bt) do { __builtin_amdgcn_s_setprio(1); _Pragma("unroll") for (int m = 0; m < 4; ++m) _Pragma("unroll") for (int n = 0; n < 2; ++n) _Pragma("unroll") for (int k = 0; k < 2; ++k) \
        acc[ai][bj][m][n] = __builtin_amdgcn_mfma_f32_16x16x32_bf16(Bt[n][k], At[m][k], acc[ai][bj][m][n], 0, 0, 0); __builtin_amdgcn_s_setprio(0); } while (0)
#define PG8_WAIT_V(n) asm volatile("s_waitcnt vmcnt(" #n ")" ::: "memory")
#define PG8_WAIT_L(n) asm volatile("s_waitcnt lgkmcnt(" #n ")" ::: "memory")
#define PG8_BAR __builtin_amdgcn_s_barrier()
#define PG8_SCHED __builtin_amdgcn_sched_barrier(0)
    Unit cur, nxt; int ui = 0;
    if (!S.next(0, cur)) return;
    f32x4 acc[2][2][4][2];
#pragma unroll
    for (int a = 0; a < 2; ++a)
#pragma unroll
        for (int b = 0; b < 2; ++b)
#pragma unroll
            for (int m = 0; m < 4; ++m)
#pragma unroll
                for (int n = 0; n < 2; ++n) acc[a][b][m][n] = (f32x4){0.f, 0.f, 0.f, 0.f};
    bf16x8 At[4][2], B0[2][2], B1[2][2];
    const char* cA = (const char*)(cur.g ? g.A1 : g.A) + (size_t)cur.pm * tstep + (size_t)cur.kp * 2; const char* cB = (const char*)(cur.g ? g.Bt1 : g.Bt) + (size_t)cur.pn * tstep + (size_t)cur.kp * 2;
    S.a_ready(cur);
    if constexpr (SP2) {
        PG8_STAGE(PG8_SB(0, 0), cB, voffB); PG8_STAGE(PG8_SB(0, 1), cB + hstep, voffB); PG8_STAGE(PG8_SA(0, 0), cA, voffA); PG8_STAGE(PG8_SA(0, 1), cA + hstep, voffA);
        if (wr == 1) PG8_BAR;
        PG8_WAIT_V(2); PG8_BAR;
        PG8_STAGE(PG8_SB(1, 0), cB + kstep, voffB); PG8_STAGE(PG8_SA(1, 0), cA + kstep, voffA); PG8_STAGE(PG8_SB(1, 1), cB + hstep + kstep, voffB);
        PG8_WAIT_V(6); PG8_BAR;
    } else {
        PG8_STAGE(PG8_SB(0, 0), cB, voffB); PG8_STAGE(PG8_SA(0, 0), cA, voffA); PG8_STAGE(PG8_SB(0, 1), cB + hstep, voffB); PG8_STAGE(PG8_SA(0, 1), cA + hstep, voffA);
        if (wr == 1) PG8_BAR;
        PG8_WAIT_V(4); PG8_BAR;
        PG8_STAGE(PG8_SB(1, 0), cB + kstep, voffB); PG8_STAGE(PG8_SA(1, 0), cA + kstep, voffA); PG8_STAGE(PG8_SB(1, 1), cB + hstep + kstep, voffB);
        PG8_WAIT_V(6); PG8_BAR;
    }
    for (;;) {
        const bool has_next = S.next(ui + 1, nxt);
        const char* nA = has_next ? (const char*)(nxt.g ? g.A1 : g.A) + (size_t)nxt.pm * tstep + (size_t)nxt.kp * 2 : cA; const char* nB = has_next ? (const char*)(nxt.g ? g.Bt1 : g.Bt) + (size_t)nxt.pn * tstep + (size_t)nxt.kp * 2 : cB;
        const int ntc = cur.nt > 0 ? cur.nt : nt;
        for (int t = 0; t < ntc; t += 2) {
            const bool last = (t == ntc - 2);
            const char* a1 = cA + (size_t)(t + 1) * kstep;
            const char* a2 = last ? nA : cA + (size_t)(t + 2) * kstep; const char* b2 = last ? nB : cB + (size_t)(t + 2) * kstep;
            const char* a3 = a2 + kstep; const char* b3 = b2 + kstep;
            if (last && has_next) S.a_ready(nxt);
            if constexpr (SP2) {
            PG8_LDB(B0, 0, 0); PG8_LDB(B1, 0, 1); PG8_SCHED; PG8_LDA(At, 0, 0); PG8_STAGE(PG8_SA(1, 1), a1 + hstep, voffA);
            PG8_WAIT_V(8); PG8_WAIT_L(0); PG8_BAR; PG8_MMA(0, 0, At, B0); PG8_MMA(0, 1, At, B1); PG8_BAR; PG8_SCHED;
            PG8_LDA(At, 0, 1); PG8_STAGE(PG8_SB(0, 0), b2, voffB); PG8_STAGE(PG8_SB(0, 1), b2 + hstep, voffB); PG8_STAGE(PG8_SA(0, 0), a2, voffA);
            PG8_WAIT_V(8); PG8_WAIT_L(0); PG8_BAR; PG8_MMA(1, 0, At, B0); PG8_MMA(1, 1, At, B1); PG8_BAR; PG8_SCHED;
            PG8_LDB(B0, 1, 0); PG8_LDB(B1, 1, 1); PG8_SCHED; PG8_LDA(At, 1, 0); PG8_STAGE(PG8_SA(0, 1), a2 + hstep, voffA);
            PG8_WAIT_V(8); PG8_WAIT_L(0); PG8_BAR; PG8_MMA(0, 0, At, B0); PG8_MMA(0, 1, At, B1); PG8_BAR; PG8_SCHED;
            PG8_LDA(At, 1, 1); PG8_STAGE(PG8_SB(1, 0), b3, voffB); PG8_STAGE(PG8_SB(1, 1), b3 + hstep, voffB); PG8_STAGE(PG8_SA(1, 0), a3, voffA);
            PG8_WAIT_V(8); PG8_WAIT_L(0); PG8_BAR; PG8_MMA(1, 0, At, B0); PG8_MMA(1, 1, At, B1); PG8_BAR; PG8_SCHED;
            } else {
            PG8_LDB(B0, 0, 0); PG8_SCHED; PG8_LDA(At, 0, 0); PG8_STAGE(PG8_SA(1, 1), a1 + hstep, voffA);
            PG8_WAIT_L(8); PG8_BAR; PG8_WAIT_L(0); PG8_MMA(0, 0, At, B0); PG8_BAR; PG8_SCHED;
            PG8_LDB(B1, 0, 1); PG8_STAGE(PG8_SB(0, 0), b2, voffB);
            PG8_BAR; PG8_WAIT_L(0); PG8_MMA(0, 1, At, B1); PG8_BAR;
            PG8_LDA(At, 0, 1); PG8_STAGE(PG8_SA(0, 0), a2, voffA);
            PG8_BAR; PG8_WAIT_L(0); PG8_MMA(1, 0, At, B0); PG8_BAR; PG8_SCHED;
            PG8_STAGE(PG8_SB(0, 1), b2 + hstep, voffB);
            PG8_WAIT_V(6); PG8_BAR; PG8_MMA(1, 1, At, B1); PG8_BAR;
            PG8_LDB(B0, 1, 0); PG8_SCHED; PG8_LDA(At, 1, 0); PG8_STAGE(PG8_SA(0, 1), a2 + hstep, voffA);
            PG8_WAIT_L(8); PG8_BAR; PG8_WAIT_L(0); PG8_MMA(0, 0, At, B0); PG8_BAR; PG8_SCHED;
            PG8_LDB(B1, 1, 1); PG8_STAGE(PG8_SB(1, 0), b3, voffB);
            PG8_BAR; PG8_WAIT_L(0); PG8_MMA(0, 1, At, B1); PG8_BAR;
            PG8_LDA(At, 1, 1); PG8_STAGE(PG8_SA(1, 0), a3, voffA);
            PG8_BAR; PG8_WAIT_L(0); PG8_MMA(1, 0, At, B0); PG8_BAR; PG8_SCHED;
            PG8_STAGE(PG8_SB(1, 1), b3 + hstep, voffB);
            PG8_WAIT_V(6); PG8_BAR; PG8_MMA(1, 1, At, B1); PG8_BAR;
            }
        }
        if constexpr (ALIGN_EPI) { if (wr == 0) PG8_BAR; }
        if constexpr (!Epi::AFTER_DRAIN) { E(acc, cur, wr, wc, fr, fq); S.done(cur); }
        if (!has_next) break;
        if (!cur.keep) {
#pragma unroll
        for (int a = 0; a < 2; ++a)
#pragma unroll
            for (int b = 0; b < 2; ++b)
#pragma unroll
                for (int m = 0; m < 4; ++m)
#pragma unroll
                    for (int n = 0; n < 2; ++n) acc[a][b][m][n] = (f32x4){0.f, 0.f, 0.f, 0.f};
        }
        cur = nxt; cA = nA; cB = nB; ++ui;
        if constexpr (ALIGN_EPI) { if (wr == 1) PG8_BAR; }
    }
    PG8_WAIT_V(0);
    if constexpr (!ALIGN_EPI) { if (wr == 0) PG8_BAR; }
    PG8_BAR;
    if constexpr (Epi::AFTER_DRAIN) { E.fused(acc, cur, wr, wc, fr, fq, lds, wid, lane); S.done(cur); }
#undef PG8_SA
#undef PG8_SB
#undef PG8_STAGE
#undef PG8_LDA
#undef PG8_LDB
#undef PG8_MMA
#undef PG8_WAIT_V
#undef PG8_WAIT_L
#undef PG8_BAR
#undef PG8_SCHED
}
}

using pg8::f32x4; using pg8::bf16x8; using pg8::u32x4; using pg8::bf16_t;
#define LAS __attribute__((address_space(3)))
typedef unsigned u32x2 __attribute__((ext_vector_type(2)));
typedef float f32x2v __attribute__((ext_vector_type(2)));

constexpr int D = 2048, SEQ = 4096, MX = 8192, MC = 512, MT = 8704, CTXL = 256;
constexpr int NH = 8, DQK = 1024, DV = 2048, DCONV = 1024, DFF = 5632;
constexpr int NINP = 12544;
constexpr float LN_EPS = 1e-5f, ALPHA = 1.189207115002721f  , QSCALE = 0.08838834764831845f;
constexpr int NWAVES = 8, NTHREADS = 512;

constexpr size_t MiB = 1u << 20;
constexpr size_t WS_MOD = 4096, WS_BAR = 256 * 1024, WS_BPERM = 512 * 1024;
constexpr size_t WS_W13A = 1 * MiB, WS_W2A = 45 * MiB, WS_WIN = 67 * MiB, WS_WM = 116 * MiB, WS_WC = 124 * MiB, WS_WO = 128 * MiB, WS_W13B = 136 * MiB, WS_W2B = 180 * MiB;
constexpr size_t WS_ACTA = 202 * MiB, WS_HBUF = 236 * MiB, WS_OBUF = 330 * MiB;
constexpr size_t WS_KB = 402 * MiB, WS_VB = 419 * MiB, WS_QB = 453 * MiB, WS_OB = 469 * MiB, WS_UB = 501 * MiB, WS_GM = 517 * MiB, WS_GC = 549 * MiB, WS_GATES = 581 * MiB, WS_AC = 583 * MiB;
constexpr size_t WS_END = 599 * MiB;

constexpr int LDS_BYTES = 135168;

__device__ __forceinline__ float bf2f(unsigned b) { return __uint_as_float(b << 16); }
__device__ __forceinline__ float bflo(unsigned w) { return __uint_as_float(w << 16); }
__device__ __forceinline__ float bfhi(unsigned w) { return __uint_as_float(w & 0xffff0000u); }
__device__ __forceinline__ unsigned pk2(float lo, float hi) { return pg8::cvt_pk_bf16(lo, hi); }
__device__ __forceinline__ float sigm(float x) { return __builtin_amdgcn_rcpf(1.f + __expf(-x)); }
#define LDS_BARRIER() do { asm volatile("s_waitcnt lgkmcnt(0)" ::: "memory"); __builtin_amdgcn_s_barrier(); asm volatile("" ::: "memory"); } while (0)
__device__ __forceinline__ float wsum(float v) {
#pragma unroll
    for (int o = 32; o >= 1; o >>= 1) v += __shfl_xor(v, o);
    return v;
}

struct Frame {
    const float *x, *c, *ctx, *c_ctx, *w_ada, *b_ada, *w_in, *b_in, *mh_g, *conv_w, *conv_b, *conv_g, *conv_bb, *w_m, *w_c, *w_o, *f1w13, *f1w2, *f2w13, *f2w2, *pg, *pb;
    float* out; unsigned char* ws;
    float *mod, *bperm, *OBUF, *GATES;
    bf16_t *W13A, *W2A, *WIN, *WM, *WC, *WO, *W13B, *W2B, *ACTA, *HBUF, *KB, *VB, *QB, *OB, *UB, *GM, *GC, *AC;
};

struct EpiSwiGLU {
    static constexpr bool PERM = true, AFTER_DRAIN = false;
    bf16_t* H;
    __device__ __forceinline__ void operator()(const f32x4 (&acc)[2][2][4][2], const pg8::Unit& u, int wr, int wc, int fr, int fq) const {
        const int row0 = u.pm * 256 + wr * 64 + fr, col0 = u.pn * 128 + wc * 32 + 8 * fq;
#pragma unroll
        for (int ai = 0; ai < 2; ++ai)
#pragma unroll
            for (int m = 0; m < 4; ++m) {
                bf16_t* p = H + (size_t)(row0 + ai * 128 + m * 16) * DFF + col0;
                float h[8];
#pragma unroll
                for (int n = 0; n < 2; ++n)
#pragma unroll
                    for (int j = 0; j < 4; ++j) { const float a = acc[ai][0][m][n][j], g = acc[ai][1][m][n][j]; h[n * 4 + j] = a * sigm(a) * g; }
                u32x4 w; w.x = pk2(h[0], h[1]); w.y = pk2(h[2], h[3]); w.z = pk2(h[4], h[5]); w.w = pk2(h[6], h[7]);
                *(u32x4*)p = w;
            }
    }
};
struct EpiNull {
    static constexpr bool PERM = true, AFTER_DRAIN = false;
    float* C;
    __device__ __forceinline__ void operator()(const f32x4 (&acc)[2][2][4][2], const pg8::Unit& u, int wr, int wc, int fr, int fq) const {
        float s = 0.f;
#pragma unroll
        for (int ai = 0; ai < 2; ++ai)
#pragma unroll
            for (int bj = 0; bj < 2; ++bj)
#pragma unroll
                for (int m = 0; m < 4; ++m)
#pragma unroll
                    for (int n = 0; n < 2; ++n) s += acc[ai][bj][m][n][0] + acc[ai][bj][m][n][1] + acc[ai][bj][m][n][2] + acc[ai][bj][m][n][3];
        if (s == 1.2345678e30f) C[u.pm] = s;
    }
};
struct EpiF32 {
    static constexpr bool PERM = false, AFTER_DRAIN = false;
    float* C;
    __device__ __forceinline__ void operator()(const f32x4 (&acc)[2][2][4][2], const pg8::Unit& u, int wr, int wc, int fr, int fq) const {
        const int row0 = u.orow + wr * 64 + fr, col0 = u.pn * 256 + wc * 32 + 4 * fq;
#pragma unroll
        for (int ai = 0; ai < 2; ++ai)
#pragma unroll
            for (int m = 0; m < 4; ++m) { float* rowp = C + (size_t)(row0 + ai * 128 + m * 16) * D + col0;
#pragma unroll
                for (int bj = 0; bj < 2; ++bj)
#pragma unroll
                    for (int n = 0; n < 2; ++n) *(f32x4*)(rowp + bj * 128 + n * 16) = acc[ai][bj][m][n]; }
    }
};
struct EpiInProj {
    static constexpr bool PERM = true, AFTER_DRAIN = false;
    const float* bias; bf16_t *KB, *VB, *QB, *OB, *UB, *GM, *GC; float* GATES;
    __device__ __forceinline__ void operator()(const f32x4 (&acc)[2][2][4][2], const pg8::Unit& u, int wr, int wc, int fr, int fq) const {
        const int pn = u.pn, row0 = u.pm * 256 + wr * 64 + fr, lc0 = wc * 32 + 8 * fq;
        if (pn == 48) {
            if (wc == 0) {
                const f32x4 b0 = *(const f32x4*)(bias + 12288 + 8 * fq), b1 = *(const f32x4*)(bias + 12288 + 8 * fq + 4);
#pragma unroll
                for (int ai = 0; ai < 2; ++ai)
#pragma unroll
                    for (int m = 0; m < 4; ++m) { float* p = GATES + (size_t)(row0 + ai * 128 + m * 16) * 32 + 8 * fq;
                        *(f32x4*)p = acc[ai][0][m][0] + b0; *(f32x4*)(p + 4) = acc[ai][0][m][1] + b1; }
            }
            return;
        }
        if (pn >= 24 && pn < 32) {
            const int col = (pn - 24) * 128 + lc0;
            const f32x4 ba0 = *(const f32x4*)(bias + pn * 256 + lc0), ba1 = *(const f32x4*)(bias + pn * 256 + lc0 + 4);
            const f32x4 bg0 = *(const f32x4*)(bias + pn * 256 + 128 + lc0), bg1 = *(const f32x4*)(bias + pn * 256 + 128 + lc0 + 4);
#pragma unroll
            for (int ai = 0; ai < 2; ++ai)
#pragma unroll
                for (int m = 0; m < 4; ++m) {
                    const f32x4 a0 = acc[ai][0][m][0] + ba0, a1 = acc[ai][0][m][1] + ba1, g0 = acc[ai][1][m][0] + bg0, g1 = acc[ai][1][m][1] + bg1;
                    u32x4 w; w.x = pk2(a0[0] * sigm(g0[0]), a0[1] * sigm(g0[1])); w.y = pk2(a0[2] * sigm(g0[2]), a0[3] * sigm(g0[3]));
                    w.z = pk2(a1[0] * sigm(g1[0]), a1[1] * sigm(g1[1])); w.w = pk2(a1[2] * sigm(g1[2]), a1[3] * sigm(g1[3]));
                    *(u32x4*)(UB + (size_t)(row0 + ai * 128 + m * 16) * DCONV + col) = w;
                }
            return;
        }
        bf16_t* dst; int ldc, cb, mode;
        if (pn < 4) { dst = KB; ldc = DQK; cb = pn * 256; mode = 0; }
        else if (pn < 12) { dst = VB; ldc = DV; cb = (pn - 4) * 256; mode = 0; }
        else if (pn < 16) { dst = QB; ldc = DQK; cb = (pn - 12) * 256; mode = 1; }
        else if (pn < 24) { dst = OB; ldc = DV; cb = (pn - 16) * 256; mode = 2; }
        else if (pn < 40) { dst = GM; ldc = D; cb = (pn - 32) * 256; mode = 2; }
        else { dst = GC; ldc = D; cb = (pn - 40) * 256; mode = 2; }
#pragma unroll
        for (int bj = 0; bj < 2; ++bj) {
            const f32x4 b0 = *(const f32x4*)(bias + pn * 256 + bj * 128 + lc0), b1 = *(const f32x4*)(bias + pn * 256 + bj * 128 + lc0 + 4);
#pragma unroll
            for (int ai = 0; ai < 2; ++ai)
#pragma unroll
                for (int m = 0; m < 4; ++m) {
                    f32x4 v0 = acc[ai][bj][m][0] + b0, v1 = acc[ai][bj][m][1] + b1;
                    if (mode == 1) { v0 = v0 * QSCALE; v1 = v1 * QSCALE; }
                    if (mode == 2) {
#pragma unroll
                        for (int j = 0; j < 4; ++j) { v0[j] = sigm(v0[j]); v1[j] = sigm(v1[j]); } }
                    u32x4 w; w.x = pk2(v0[0], v0[1]); w.y = pk2(v0[2], v0[3]); w.z = pk2(v1[0], v1[1]); w.w = pk2(v1[2], v1[3]);
                    *(u32x4*)(dst + (size_t)(row0 + ai * 128 + m * 16) * ldc + cb + bj * 128 + lc0) = w;
                }
        }
    }
};
struct InProjOrder {
    pg8::StaticOrder so;
    __device__ void init(int G, int c) { so.init(MX, NINP, G, c); }
    __device__ bool next(int i, pg8::Unit& u) const {
        if (so.next(i, u)) return true;
        const long L = (long)i * so.G + so.c - so.nwg; if (L >= 26) return false;
        const int j = (int)L % 13; u.pm = 32 + (int)L / 13; u.pn = j < 12 ? j : 48; u.kp = 0; u.nt = 0; u.g = 0; u.keep = 0; u.orow = u.pm * 256; return true;
    }
    __device__ __forceinline__ void a_ready(const pg8::Unit&) const {}
    __device__ __forceinline__ void done(const pg8::Unit&) const {}
};

constexpr int CTX_KSPLIT = 11;
struct FfnDownOrder {
    pg8::StaticOrder so;
    __device__ void init(int G, int c) { so.init(MX, D, G, c); }
    __device__ bool next(int i, pg8::Unit& u) const {
        if (so.next(i, u)) return true;
        const long L = (long)i * so.G + so.c - so.nwg; if (L >= 16 * CTX_KSPLIT) return false;
        const int t = (int)L / CTX_KSPLIT, p = (int)L % CTX_KSPLIT; u.kp = p * (DFF / CTX_KSPLIT); u.pm = 32 + (t >> 3); u.pn = t & 7; u.nt = DFF / CTX_KSPLIT / 64; u.g = 0; u.keep = 0; u.orow = MX + p * MC + (t >> 3) * 256; return true;
    }
    __device__ __forceinline__ void a_ready(const pg8::Unit&) const {}
    __device__ __forceinline__ void done(const pg8::Unit&) const {}
};
struct MergeOrder {
    pg8::StaticOrder so;
    __device__ void init(int G, int c) { so.init(MX, D, G, c); }
    __device__ bool next(int i, pg8::Unit& u) const {
        if (!so.next(i >> 1, u)) return false;
        if (i & 1) { u.g = 1; u.nt = DV / 64; u.keep = 0; } else { u.g = 0; u.nt = DCONV / 64; u.keep = 1; }
        return true;
    }
    __device__ __forceinline__ void a_ready(const pg8::Unit&) const {}
    __device__ __forceinline__ void done(const pg8::Unit&) const {}
};
struct EpiMerge2 {
    static constexpr bool PERM = true, AFTER_DRAIN = false;
    const bf16_t* GC; const bf16_t* GM; bf16_t* O;
    __device__ __forceinline__ void operator()(f32x4 (&acc)[2][2][4][2], const pg8::Unit& u, int wr, int wc, int fr, int fq) const {
        const int row0 = u.pm * 256 + wr * 64 + fr, col0 = u.pn * 256 + wc * 32 + 8 * fq;
#pragma unroll
        for (int ai = 0; ai < 2; ++ai)
#pragma unroll
            for (int m = 0; m < 4; ++m)
#pragma unroll
                for (int bj = 0; bj < 2; ++bj) {
                    const size_t o = (size_t)(row0 + ai * 128 + m * 16) * D + col0 + bj * 128;
                    const u32x4 gm = *(const u32x4*)(GM + o);
                    float g[8]; g[0] = bflo(gm.x); g[1] = bfhi(gm.x); g[2] = bflo(gm.y); g[3] = bfhi(gm.y); g[4] = bflo(gm.z); g[5] = bfhi(gm.z); g[6] = bflo(gm.w); g[7] = bfhi(gm.w);
                    if (u.g == 0) {
                        const u32x4 gc = *(const u32x4*)(GC + o);
                        float c[8]; c[0] = bflo(gc.x); c[1] = bfhi(gc.x); c[2] = bflo(gc.y); c[3] = bfhi(gc.y); c[4] = bflo(gc.z); c[5] = bfhi(gc.z); c[6] = bflo(gc.w); c[7] = bfhi(gc.w);
#pragma unroll
                        for (int j = 0; j < 4; ++j) { acc[ai][bj][m][0][j] *= c[j] / g[j]; acc[ai][bj][m][1][j] *= c[4 + j] / g[4 + j]; }
                    } else {
                        const f32x4 a0 = acc[ai][bj][m][0], a1 = acc[ai][bj][m][1];
                        u32x4 w; w.x = pk2(a0[0] * g[0], a0[1] * g[1]); w.y = pk2(a0[2] * g[2], a0[3] * g[3]); w.z = pk2(a1[0] * g[4], a1[1] * g[5]); w.w = pk2(a1[2] * g[6], a1[3] * g[7]);
                        *(u32x4*)(O + o) = w;
                    }
                }
    }
};

__device__ __forceinline__ int map_col(int mode, int n) {
    if (mode == 0) return n;
    if (mode == 1) { const int t = n >> 8, i = n & 255; return i < 128 ? 128 * t + i : DFF + 128 * t + (i - 128); }
    if (n < 3072) return n;
    if (n < 4096) return 3104 + (n - 3072);
    if (n < 6144) return 4128 + (n - 4096);
    if (n < 8192) { const int t = (n - 6144) >> 8, i = (n - 6144) & 255; return i < 128 ? 6176 + 128 * t + i : 6176 + 1024 + 128 * t + (i - 128); }
    if (n < 12288) return 8224 + (n - 8192);
    if (n < 12320) return 3072 + (n - 12288);
    return -1;
}
__device__ __forceinline__ void adaln_group(const Frame& F, int grp, LAS unsigned char* lds) {
    LAS float* sc = (LAS float*)lds;
    LAS float* red = (LAS float*)(lds + 3 * 2048 * 4);
    const int tid = threadIdx.x;
    for (int i = tid; i < 3 * 2048; i += NTHREADS) { const int r = i >> 11, k = i & 2047; const float v = r < 2 ? F.c[r * 2048 + k] : F.c_ctx[k]; sc[i] = v * (1.f / (1.f + expf(-v))); }
    __syncthreads();
    const int c4 = tid % 18, kg = tid / 18, n0 = grp * 72 + c4 * 4;
    f32x4 a0 = {0.f, 0.f, 0.f, 0.f}, a1 = a0, a2 = a0;
    if (kg < 28) {
        const float* wp = F.w_ada + n0;
        int k = kg;
        for (; k + 28 * 7 < 2048; k += 28 * 8) {
            f32x4 wv[8];
#pragma unroll
            for (int u = 0; u < 8; ++u) wv[u] = __builtin_nontemporal_load((const f32x4*)(wp + (size_t)(k + 28 * u) * (9 * D)));
#pragma unroll
            for (int u = 0; u < 8; ++u) { const int kk = k + 28 * u; a0 += wv[u] * sc[kk]; a1 += wv[u] * sc[2048 + kk]; a2 += wv[u] * sc[4096 + kk]; }
        }
        for (; k < 2048; k += 28) { const f32x4 w = __builtin_nontemporal_load((const f32x4*)(wp + (size_t)k * (9 * D))); a0 += w * sc[k]; a1 += w * sc[2048 + k]; a2 += w * sc[4096 + k]; }
        LAS float* p = red + (kg * 18 + c4) * 12;
        *(LAS f32x4*)p = a0; *(LAS f32x4*)(p + 4) = a1; *(LAS f32x4*)(p + 8) = a2;
    }
    __syncthreads();
    if (tid < 216) {
        const int cc = tid / 12, e = tid % 12, r = e >> 2, j = e & 3; float s = 0.f;
        for (int g = 0; g < 28; ++g) s += red[(g * 18 + cc) * 12 + e];
        const int n = grp * 72 + cc * 4 + j;
        F.mod[r * (9 * D) + n] = s + F.b_ada[n];
    }
    __syncthreads();
}
struct CvtTile { const float* W; bf16_t* Bt; int Nsrc, ldb, k0, n0, mode; };
__device__ __forceinline__ void cvt_load(const CvtTile& t, f32x4 (&v)[8]) {
    const int tid = threadIdx.x, n4 = tid & 63, kgrp = tid >> 6;
    const int src = map_col(t.mode, t.n0 + 4 * n4), kb = t.k0 + 8 * kgrp;
    if (src >= 0) {
#pragma unroll
        for (int i = 0; i < 8; ++i) v[i] = __builtin_nontemporal_load((const f32x4*)(t.W + (size_t)(kb + i) * t.Nsrc + src));
    } else {
#pragma unroll
        for (int i = 0; i < 8; ++i) v[i] = (f32x4){0.f, 0.f, 0.f, 0.f};
    }
}
__device__ __forceinline__ void cvt_to_lds(const f32x4 (&v)[8], LAS bf16_t* buf) {
    const int tid = threadIdx.x, n4 = tid & 63, kgrp = tid >> 6;
#pragma unroll
    for (int c = 0; c < 4; ++c) { u32x4 w; w.x = pk2(v[0][c], v[1][c]); w.y = pk2(v[2][c], v[3][c]); w.z = pk2(v[4][c], v[5][c]); w.w = pk2(v[6][c], v[7][c]);
        *(LAS u32x4*)(buf + (4 * n4 + c) * 72 + 8 * kgrp) = w; }
}
__device__ __forceinline__ void cvt_store(const CvtTile& t, const LAS bf16_t* buf) {
    const int tid = threadIdx.x;
#pragma unroll
    for (int it = 0; it < 4; ++it) { const int id = it * NTHREADS + tid, row = id >> 3, ch = id & 7;
        const u32x4 w = *(const LAS u32x4*)(buf + row * 72 + 8 * ch);
        *(u32x4*)(t.Bt + (size_t)(t.n0 + row) * t.ldb + t.k0 + 8 * ch) = w; }
}
__device__ __forceinline__ bool cvt_pick(const Frame& F, int T, CvtTile& ct) {
    constexpr int T0 = 1408, T1 = 704, T2 = 1568, T3 = 256, T4 = 128, T5 = 256, T6 = 1408, T7 = 704, TT = T0 + T1 + T2 + T3 + T4 + T5 + T6 + T7;
    if (T >= TT) return false;
    int t = T, K, Np;
    if (t < T0) { ct.W = F.f1w13; ct.Bt = F.W13A; ct.Nsrc = 2 * DFF; K = D; Np = 2 * DFF; ct.mode = 1; ct.ldb = K; }
    else if ((t -= T0) < T1) { ct.W = F.f1w2; ct.Bt = F.W2A; ct.Nsrc = D; K = DFF; Np = D; ct.mode = 0; ct.ldb = K; }
    else if ((t -= T1) < T2) { ct.W = F.w_in; ct.Bt = F.WIN; ct.Nsrc = 12320; K = D; Np = NINP; ct.mode = 2; ct.ldb = K; }
    else if ((t -= T2) < T3) { ct.W = F.w_m; ct.Bt = F.WM; ct.Nsrc = D; K = DV; Np = D; ct.mode = 0; ct.ldb = K; }
    else if ((t -= T3) < T4) { ct.W = F.w_c; ct.Bt = F.WC; ct.Nsrc = D; K = DCONV; Np = D; ct.mode = 0; ct.ldb = D; }
    else if ((t -= T4) < T5) { ct.W = F.w_o; ct.Bt = F.WO; ct.Nsrc = D; K = D; Np = D; ct.mode = 0; ct.ldb = K; }
    else if ((t -= T5) < T6) { ct.W = F.f2w13; ct.Bt = F.W13B; ct.Nsrc = 2 * DFF; K = D; Np = 2 * DFF; ct.mode = 1; ct.ldb = K; }
    else { t -= T6; ct.W = F.f2w2; ct.Bt = F.W2B; ct.Nsrc = D; K = DFF; Np = D; ct.mode = 0; ct.ldb = K; }
    const int ntn = Np / 256; ct.n0 = (t % ntn) * 256; ct.k0 = (t / ntn) * 64; (void)K;
    return true;
}
__device__ __forceinline__ void p0_prep(const Frame& F, LAS unsigned char* lds) {
    for (int g = blockIdx.x; g < 256; g += gridDim.x) adaln_group(F, g, lds);
    for (int i = blockIdx.x * NTHREADS + threadIdx.x; i < NINP; i += gridDim.x * NTHREADS) { const int s = map_col(2, i); F.bperm[i] = s >= 0 ? F.b_in[s] : 0.f; }
    LAS bf16_t* buf0 = (LAS bf16_t*)lds; LAS bf16_t* buf1 = buf0 + 256 * 72;
    CvtTile cur, nxt; f32x4 v[8];
    bool have = cvt_pick(F, blockIdx.x, cur);
    if (have) cvt_load(cur, v);
    int par = 0;
    for (int T = blockIdx.x; have; T += gridDim.x) {
        LAS bf16_t* buf = par ? buf1 : buf0; par ^= 1;
        cvt_to_lds(v, buf);
        const bool hn = cvt_pick(F, T + gridDim.x, nxt);
        if (hn) cvt_load(nxt, v);
        LDS_BARRIER();
        cvt_store(cur, buf);
        cur = nxt; have = hn;
    }
    __syncthreads();
}

__device__ __forceinline__ void store_modin(const f32x4 (&y)[8], const float* modr, int sub, bf16_t* arow, int lane) {
    const float* shift = modr + (sub * 3 + 0) * D; const float* scale = modr + (sub * 3 + 1) * D;
#pragma unroll
    for (int i = 0; i < 8; ++i) { const int idx = (i * 64 + lane) * 4; const f32x4 s = *(const f32x4*)(scale + idx), sh = *(const f32x4*)(shift + idx);
        const f32x4 o = y[i] * (s + 1.f) + sh; u32x2 w; w.x = pk2(o[0], o[1]); w.y = pk2(o[2], o[3]); *(u32x2*)(arow + idx) = w; }
}
__device__ __forceinline__ void p_modin0(const Frame& F) {
    const int lane = threadIdx.x & 63, wv = threadIdx.x >> 6;
    for (int row = blockIdx.x * NWAVES + wv; row < MT; row += gridDim.x * NWAVES) {
        const float* src = row < MX ? F.x + (size_t)row * D : F.ctx + (size_t)(row - MX) * D;
        const int r = row < MX ? row >> 12 : 2;
        f32x4 y[8];
#pragma unroll
        for (int i = 0; i < 8; ++i) y[i] = *(const f32x4*)(src + (i * 64 + lane) * 4);
        store_modin(y, F.mod + r * 9 * D, 0, F.ACTA + (size_t)row * D, lane);
    }
}
template <int SUB> __device__ __forceinline__ void p_residual(const Frame& F, float weight, int nrows, const float* PART) {
    const int lane = threadIdx.x & 63, wv = threadIdx.x >> 6;
    for (int row = blockIdx.x * NWAVES + wv; row < nrows; row += gridDim.x * NWAVES) {
        const bool isx = row < MX;
        const float* xin = isx ? ((SUB == 0 ? F.x : (const float*)F.out) + (size_t)row * D) : F.ctx + (size_t)(row - MX) * D;
        const int r = isx ? row >> 12 : 2;
        const float* modr = F.mod + r * 9 * D; const float* gate = modr + (SUB * 3 + 2) * D;
        const float* orow = F.OBUF + (size_t)row * D; const float* lg = F.pg + SUB * D; const float* lb = F.pb + SUB * D;
        f32x4 v[8]; float s = 0.f;
#pragma unroll
        for (int i = 0; i < 8; ++i) { const int idx = (i * 64 + lane) * 4; const f32x4 xv = *(const f32x4*)(xin + idx), gv = *(const f32x4*)(gate + idx); f32x4 ov;
            if (isx) ov = *(const f32x4*)(orow + idx);
            else { ov = (f32x4){0.f, 0.f, 0.f, 0.f};
#pragma unroll
                for (int p = 0; p < CTX_KSPLIT; ++p) ov += *(const f32x4*)(PART + ((size_t)p * MC + (row - MX)) * D + idx); }
            v[i] = xv * ALPHA + (gv * weight) * ov; s += (v[i][0] + v[i][1]) + (v[i][2] + v[i][3]); }
        const float mean = wsum(s) * (1.f / D); float q = 0.f;
#pragma unroll
        for (int i = 0; i < 8; ++i) { v[i] = v[i] - mean; q += (v[i][0] * v[i][0] + v[i][1] * v[i][1]) + (v[i][2] * v[i][2] + v[i][3] * v[i][3]); }
        const float rstd = rsqrtf(wsum(q) * (1.f / D) + LN_EPS);
#pragma unroll
        for (int i = 0; i < 8; ++i) { const int idx = (i * 64 + lane) * 4; v[i] = v[i] * rstd * *(const f32x4*)(lg + idx) + *(const f32x4*)(lb + idx);
            if (isx) *(f32x4*)(F.out + (size_t)row * D + idx) = v[i]; }
        if (SUB < 2) store_modin(v, modr, SUB + 1, F.ACTA + (size_t)row * D, lane);
    }
}
__device__ __forceinline__ void p_headnorm(const Frame& F, const float* HF0, const float* HF1, bf16_t* AM) {
    const int lane = threadIdx.x & 63, wv = threadIdx.x >> 6;
    for (int row = blockIdx.x * NWAVES + wv; row < MX; row += gridDim.x * NWAVES) {
#pragma unroll
        for (int hh = 0; hh < NH; ++hh) {
            const size_t o = (size_t)row * DV + hh * 256 + lane * 4;
            f32x4 v = *(const f32x4*)(HF0 + o) + *(const f32x4*)(HF1 + o);
            const float mean = wsum((v[0] + v[1]) + (v[2] + v[3])) * (1.f / 256.f);
            v = v - mean;
            const float rstd = rsqrtf(wsum((v[0] * v[0] + v[1] * v[1]) + (v[2] * v[2] + v[3] * v[3])) * (1.f / 256.f) + LN_EPS);
            const f32x4 g = *(const f32x4*)(F.mh_g + hh * 256 + lane * 4); const u32x2 so = *(const u32x2*)(F.OB + o);
            v = v * rstd * g;
            u32x2 w; w.x = pk2(v[0] * bflo(so.x), v[1] * bfhi(so.x)); w.y = pk2(v[2] * bflo(so.y), v[3] * bfhi(so.y));
            *(u32x2*)(AM + o) = w;
        }
    }
}

constexpr int LP = 136;
constexpr int L_Q = 0, L_K = 34816, L_KT = 69632, L_VT = 104448, L_CT = 117504, L_ARR = 130560;
__device__ __forceinline__ float logsig(float x) { return fminf(x, 0.f) - log1pf(expf(-fabsf(x))); }
__device__ __forceinline__ int chunk_row0(int cc, int dir, int b) { if (cc < 2) { const int ci = dir ? 1 - cc : cc; return MX + b * CTXL + ci * 128; } const int xi = dir ? 33 - cc : cc - 2; return b * SEQ + xi * 128; }
__device__ __forceinline__ unsigned short hsel(const u32x4& v, int i) { const unsigned w = (i >> 1) == 0 ? v.x : (i >> 1) == 1 ? v.y : (i >> 1) == 2 ? v.z : v.w; return (unsigned short)((i & 1) ? (w >> 16) : (w & 0xffffu)); }

__device__ __forceinline__ float ml_scan(const float (&gi)[2], const float (&gf)[2], float m_run, int lane, LAS float* cU) {
    LAS float* cM = cU + 128; LAS float* cB = cU + 256; LAS float* cW = cU + 384; LAS float* cS = cU + 512;
    const float lf0 = logsig(gf[0]), lf1 = logsig(gf[1]), p = lf0 + lf1; float incl = p;
#pragma unroll
    for (int o = 1; o < 64; o <<= 1) { const float t = __shfl_up(incl, o); if (lane >= o) incl += t; }
    const float b0 = incl - p + lf0, b1 = incl, u0 = gi[0] - b0, u1 = gi[1] - b1;
    float im = fmaxf(u0, u1);
#pragma unroll
    for (int o = 1; o < 64; o <<= 1) { const float t = __shfl_up(im, o); if (lane >= o) im = fmaxf(im, t); }
    float ex = __shfl_up(im, 1); if (lane == 0) ex = -INFINITY;
    const float pm0 = fmaxf(ex, u0), pm1 = fmaxf(pm0, u1);
    const float g = __shfl(b1, 63), pml = __shfl(pm1, 63);
    const float Ml = fmaxf(m_run, pml);
    *(LAS f32x2v*)(cU + 2 * lane) = (f32x2v){u0, u1}; *(LAS f32x2v*)(cM + 2 * lane) = (f32x2v){fmaxf(m_run, pm0), fmaxf(m_run, pm1)};
    *(LAS f32x2v*)(cB + 2 * lane) = (f32x2v){b0, b1}; *(LAS f32x2v*)(cW + 2 * lane) = (f32x2v){__expf(u0 - Ml), __expf(u1 - Ml)};
    if (lane == 0) { cS[0] = __expf(m_run - Ml); cS[1] = m_run; }
    return g + Ml;
}
__device__ __forceinline__ void mlstm_unit(const Frame& F, int unit, LAS unsigned char* lds, float* HF0, float* HF1) {
    const int tid = threadIdx.x, lane = tid & 63, w = __builtin_amdgcn_readfirstlane(tid >> 6), l15 = lane & 15, q = lane >> 4;
    const int dir = unit >> 7, b = (unit >> 6) & 1, h = (unit >> 3) & 7, sl = unit & 7;
    LAS bf16_t* sQ = (LAS bf16_t*)(lds + L_Q); LAS bf16_t* sK = (LAS bf16_t*)(lds + L_K); LAS bf16_t* sKt = (LAS bf16_t*)(lds + L_KT);
    LAS bf16_t* sVt = (LAS bf16_t*)(lds + L_VT); LAS bf16_t* sCt = (LAS bf16_t*)(lds + L_CT);
    LAS float* sU = (LAS float*)(lds + L_ARR);
    float* HF = dir ? HF1 : HF0;
    for (int i = tid; i < 16 * LP; i += NTHREADS) sVt[32 * LP + i] = (i < LP) ? (bf16_t)0x3F80 : (bf16_t)0;
    for (int i = tid; i < 48 * LP; i += NTHREADS) sCt[i] = 0;
    f32x4 accC[3];
#pragma unroll
    for (int nt = 0; nt < 3; ++nt) accC[nt] = (f32x4){0.f, 0.f, 0.f, 0.f};
    float m_run = -1e4f;
    const int rg = tid >> 4, cgp = tid & 15;
    u32x4 kreg[4], qreg[4]; unsigned vreg[4]; float gi[2], gf[2];
    const int kcol = h * 128 + 8 * cgp, vcol = h * 256 + sl * 32 + 2 * cgp, gcol = dir * 16 + h;
#pragma unroll
    for (int r = 0; r < 4; ++r) qreg[r] = (u32x4){0u, 0u, 0u, 0u};
    gi[0] = gi[1] = gf[0] = gf[1] = 0.f;
#define ML_LOAD(cc) do { const int _r0 = chunk_row0((cc), dir, b); \
        _Pragma("unroll") for (int r = 0; r < 4; ++r) { const int j = 4 * rg + r; const size_t row = (size_t)(_r0 + (dir ? 127 - j : j)); \
            kreg[r] = *(const u32x4*)(F.KB + row * DQK + kcol); if ((cc) >= 2) qreg[r] = *(const u32x4*)(F.QB + row * DQK + kcol); vreg[r] = *(const unsigned*)(F.VB + row * DV + vcol); } } while (0)
#define ML_LOADG(cc) do { const int _r0 = chunk_row0((cc), dir, b); \
        _Pragma("unroll") for (int e = 0; e < 2; ++e) { const int j = 2 * lane + e; const size_t row = (size_t)(_r0 + (dir ? 127 - j : j)); gi[e] = F.GATES[row * 32 + gcol]; gf[e] = F.GATES[row * 32 + gcol + 8]; } } while (0)
    ML_LOAD(0);
    if (w == 0) { ML_LOADG(0); m_run = ml_scan(gi, gf, m_run, lane, sU); ML_LOADG(1); }
    for (int cc = 0; cc < 34; ++cc) {
        const bool isx = cc >= 2;
        const int row0 = chunk_row0(cc, dir, b);
#pragma unroll
        for (int r = 0; r < 4; ++r) { *(LAS u32x4*)(sK + (4 * rg + r) * LP + 8 * cgp) = kreg[r]; if (isx) *(LAS u32x4*)(sQ + (4 * rg + r) * LP + 8 * cgp) = qreg[r]; }
#pragma unroll
        for (int i = 0; i < 8; ++i) { const int d = 8 * cgp + i; u32x2 wv; wv.x = (unsigned)hsel(kreg[0], i) | ((unsigned)hsel(kreg[1], i) << 16); wv.y = (unsigned)hsel(kreg[2], i) | ((unsigned)hsel(kreg[3], i) << 16);
            *(LAS u32x2*)(sKt + d * LP + 8 * ((rg >> 1) ^ (cgp & 7)) + 4 * (rg & 1)) = wv; }
#pragma unroll
        for (int i = 0; i < 2; ++i) { const int e = 2 * cgp + i; u32x2 wv;
            wv.x = (i ? (vreg[0] >> 16) : (vreg[0] & 0xffffu)) | ((i ? (vreg[1] >> 16) : (vreg[1] & 0xffffu)) << 16);
            wv.y = (i ? (vreg[2] >> 16) : (vreg[2] & 0xffffu)) | ((i ? (vreg[3] >> 16) : (vreg[3] & 0xffffu)) << 16);
            *(LAS u32x2*)(sVt + e * LP + 4 * rg) = wv; }
        if (cc + 1 < 34) ML_LOAD(cc + 1);
        LDS_BARRIER();
        if (w == 0 && cc + 1 < 34) { m_run = ml_scan(gi, gf, m_run, lane, sU + ((cc + 1) & 1) * 528); if (cc + 2 < 34) ML_LOADG(cc + 2); }
        LAS float* cU = sU + (cc & 1) * 528; LAS float* cM = cU + 128; LAS float* cB = cU + 256; LAS float* cW = cU + 384; LAS float* cS = cU + 512;
        if (isx) {
            bf16x8 qf[4];
#pragma unroll
            for (int ks = 0; ks < 4; ++ks) qf[ks] = *(const LAS bf16x8*)(sQ + (16 * w + l15) * LP + 32 * ks + 8 * q);
            f32x4 accO[3];
#pragma unroll
            for (int nt = 0; nt < 3; ++nt) accO[nt] = (f32x4){0.f, 0.f, 0.f, 0.f};
#pragma unroll
            for (int ks = 0; ks < 4; ++ks)
#pragma unroll
                for (int nt = 0; nt < 3; ++nt) { const bf16x8 bfr = *(const LAS bf16x8*)(sCt + (16 * nt + l15) * LP + 32 * ks + 8 * q); accO[nt] = __builtin_amdgcn_mfma_f32_16x16x32_bf16(qf[ks], bfr, accO[nt], 0, 0, 0); }
            const float m_old = cS[1];
#pragma unroll
            for (int i = 0; i < 4; ++i) { const float wi = __expf(m_old - cM[16 * w + 4 * q + i]);
#pragma unroll
                for (int nt = 0; nt < 3; ++nt) accO[nt][i] *= wi; }
            const float Mj = cM[16 * w + l15];
            for (int mt = 0; mt <= w; ++mt) {
                f32x4 s = (f32x4){0.f, 0.f, 0.f, 0.f};
#pragma unroll
                for (int ks = 0; ks < 4; ++ks) { const bf16x8 a = *(const LAS bf16x8*)(sK + (16 * mt + l15) * LP + 32 * ks + 8 * q); s = __builtin_amdgcn_mfma_f32_16x16x32_bf16(a, qf[ks], s, 0, 0, 0); }
                const f32x4 uu = *(const LAS f32x4*)(cU + 16 * mt + 4 * q);
                float pv[4];
#pragma unroll
                for (int i = 0; i < 4; ++i) { const float e = s[i] * __expf(uu[i] - Mj); pv[i] = (mt == w && (4 * q + i) > l15) ? 0.f : e; }
                u32x2 wv; wv.x = pk2(pv[0], pv[1]); wv.y = pk2(pv[2], pv[3]);
                *(LAS u32x2*)(sQ + (16 * w + l15) * LP + 16 * mt + 4 * q) = wv;
            }
            if (!(w & 1)) { u32x2 z; z.x = 0u; z.y = 0u; *(LAS u32x2*)(sQ + (16 * w + l15) * LP + 16 * (w + 1) + 4 * q) = z; }
            const int nks = (w >> 1) + 1;
            for (int ks = 0; ks < nks; ++ks) {
                const bf16x8 a = *(const LAS bf16x8*)(sQ + (16 * w + l15) * LP + 32 * ks + 8 * q);
#pragma unroll
                for (int nt = 0; nt < 3; ++nt) { const bf16x8 bfr = *(const LAS bf16x8*)(sVt + (16 * nt + l15) * LP + 32 * ks + 8 * q); accO[nt] = __builtin_amdgcn_mfma_f32_16x16x32_bf16(a, bfr, accO[nt], 0, 0, 0); }
            }
#pragma unroll
            for (int i = 0; i < 4; ++i) {
                const int j = 16 * w + 4 * q + i;
                const float den = __shfl(accO[2][i], lane & 48);
                const float dd = fmaxf(fabsf(den), __expf(-(cB[j] + cM[j]))), inv = 1.f / dd;
                float* hp = HF + (size_t)(row0 + (dir ? 127 - j : j)) * DV + h * 256 + sl * 32 + l15;
                hp[0] = accO[0][i] * inv; hp[16] = accO[1][i] * inv;
            }
        }
        {
            const float decay = cS[0];
#pragma unroll
            for (int nt = 0; nt < 3; ++nt) accC[nt] = accC[nt] * decay;
            const int d = 16 * w + l15;
#pragma unroll
            for (int ks = 0; ks < 4; ++ks) {
                const u32x4 kv = *(const LAS u32x4*)(sKt + d * LP + 8 * ((4 * ks + q) ^ ((d >> 3) & 7)));
                const f32x4 w0 = *(const LAS f32x4*)(cW + 32 * ks + 8 * q), w1 = *(const LAS f32x4*)(cW + 32 * ks + 8 * q + 4);
                u32x4 av; av.x = pk2(bflo(kv.x) * w0[0], bfhi(kv.x) * w0[1]); av.y = pk2(bflo(kv.y) * w0[2], bfhi(kv.y) * w0[3]);
                av.z = pk2(bflo(kv.z) * w1[0], bfhi(kv.z) * w1[1]); av.w = pk2(bflo(kv.w) * w1[2], bfhi(kv.w) * w1[3]);
                const bf16x8 a = __builtin_bit_cast(bf16x8, av);
#pragma unroll
                for (int nt = 0; nt < 3; ++nt) { const bf16x8 bfr = *(const LAS bf16x8*)(sVt + (16 * nt + l15) * LP + 32 * ks + 8 * q); accC[nt] = __builtin_amdgcn_mfma_f32_16x16x32_bf16(a, bfr, accC[nt], 0, 0, 0); }
            }
        }
        LDS_BARRIER();
#pragma unroll
        for (int nt = 0; nt < 3; ++nt) { u32x2 wv; wv.x = pk2(accC[nt][0], accC[nt][1]); wv.y = pk2(accC[nt][2], accC[nt][3]); *(LAS u32x2*)(sCt + (16 * nt + l15) * LP + 16 * w + 4 * q) = wv; }
    }
#undef ML_LOAD
#undef ML_LOADG
    __syncthreads();
}

__device__ __forceinline__ void conv_unit(const Frame& F, int unit, LAS unsigned char* lds) {
    const int tid = threadIdx.x, lane = tid & 63, wv = tid >> 6, c0 = 2 * tid;
    const int b = unit >> 7, r = (unit >> 1) & 63, half = unit & 1;
    const bf16_t* U = F.UB + (size_t)(b * SEQ) * DCONV + c0;
    float y0[32], y1[32];
#pragma unroll
    for (int j = 0; j < 32; ++j) { y0[j] = 0.f; y1[j] = 0.f; }
    if (tid < 256) {
        float w0[31], w1[31];
#pragma unroll
        for (int k = 0; k < 31; ++k) { const f32x2v ww = *(const f32x2v*)(F.conv_w + k * DCONV + c0); w0[k] = ww.x; w1[k] = ww.y; }
#pragma unroll
        for (int i = 0; i < 62; ++i) {
            const int col = half * 32 - 15 + i; float u0 = 0.f, u1 = 0.f;
            if (col >= 0 && col < 64) { const unsigned v = *(const unsigned*)(U + (size_t)(r * 64 + col) * DCONV); u0 = bflo(v); u1 = bfhi(v); }
#pragma unroll
            for (int j = 0; j < 32; ++j) { const int k = i - j; if (k >= 0 && k <= 30) { y0[j] += w0[k] * u0; y1[j] += w1[k] * u1; } }
        }
    } else {
        for (int k = 0; k < 31; ++k) {
            const int rr = r + k - 15; if (rr < 0 || rr >= 64) continue;
            const f32x2v ww = *(const f32x2v*)(F.conv_w + k * DCONV + c0);
            const bf16_t* up = U + (size_t)(rr * 64 + half * 32) * DCONV;
#pragma unroll
            for (int j = 0; j < 32; ++j) { const unsigned v = *(const unsigned*)(up + (size_t)j * DCONV); y0[j] += ww.x * bflo(v); y1[j] += ww.y * bfhi(v); }
        }
    }
    const f32x2v cb = *(const f32x2v*)(F.conv_b + c0);
    LAS float* red = (LAS float*)lds;
    LAS float* stat = red + 512;
#pragma unroll
    for (int j = 0; j < 32; ++j) {
        y0[j] += cb.x; y1[j] += cb.y;
        const float s1 = wsum(y0[j] + y1[j]), s2 = wsum(y0[j] * y0[j] + y1[j] * y1[j]);
        if (lane == 0) { red[wv * 64 + j] = s1; red[wv * 64 + 32 + j] = s2; }
    }
    __syncthreads();
    if (tid < 32) { float a = 0.f, q = 0.f;
#pragma unroll
        for (int g = 0; g < 8; ++g) { a += red[g * 64 + tid]; q += red[g * 64 + 32 + tid]; }
        const float mean = a * (1.f / DCONV), var = fmaxf(q * (1.f / DCONV) - mean * mean, 0.f);
        stat[2 * tid] = mean; stat[2 * tid + 1] = rsqrtf(var + LN_EPS); }
    __syncthreads();
    const f32x2v lg = *(const f32x2v*)(F.conv_g + c0), lb = *(const f32x2v*)(F.conv_bb + c0);
    bf16_t* ap = F.AC + (size_t)(b * SEQ + r * 64 + half * 32) * D + c0;
#pragma unroll
    for (int j = 0; j < 32; ++j) {
        const float mean = stat[2 * j], rstd = stat[2 * j + 1];
        const float a0 = (y0[j] - mean) * rstd * lg.x + lb.x, a1 = (y1[j] - mean) * rstd * lg.y + lb.y;
        *(unsigned*)(ap + (size_t)j * D) = pk2(a0 * sigm(a0), a1 * sigm(a1));
    }
    __syncthreads();
}

typedef unsigned v4u_unused __attribute__((ext_vector_type(4)));
#define XB_TMO      128
#define XB_XCNT(j)  (256  + 64 * (j))
#define XB_XSUB(j)  (1280 + 64 * (j))
#define XB_XGEN(j)  (2304 + 64 * (j))
#define XB_TOP      3328
#define XB_TOPGEN   3392
#define XCD_BAR_WORDS 3456
#define XB_SPIN_CAP (1u << 18)

__device__ __forceinline__ unsigned xb_ld(unsigned* p)              { return __hip_atomic_load(p, __ATOMIC_RELAXED, __HIP_MEMORY_SCOPE_AGENT); }
__device__ __forceinline__ unsigned xb_add(unsigned* p, unsigned v) { return __hip_atomic_fetch_add(p, v, __ATOMIC_RELAXED, __HIP_MEMORY_SCOPE_AGENT); }
__device__ __forceinline__ unsigned xb_xcc_id() { return (unsigned)__builtin_amdgcn_s_getreg((3 << 11) | 20) & 0xFu; }
#define XB_SPIN(cond, bar) do { unsigned _sp = 0; while (cond) { __builtin_amdgcn_s_sleep(1); \
    if ((++_sp & 255u) == 0u) { if (xb_ld(&(bar)[XB_TMO])) break; if (_sp > XB_SPIN_CAP) { atomicAdd(&(bar)[XB_TMO], 1u); break; } } } } while (0)

struct XcdBarrier {
    unsigned* bar; unsigned x;
    volatile LAS unsigned* st;
};

__device__ __forceinline__ XcdBarrier xcd_barrier_post(unsigned* bar, volatile LAS unsigned* st) {
    XcdBarrier b; b.bar = bar; b.x = xb_xcc_id(); b.st = st;
    if (threadIdx.x == 0) (void)xb_add(&bar[XB_XCNT(b.x)], 1u);
    return b;
}
__device__ __forceinline__ void xcd_barrier_complete(unsigned* bar, unsigned x, unsigned& nloc, unsigned& nx) {
    const unsigned G = gridDim.x * gridDim.y * gridDim.z;
    unsigned sum, cnt, mine, sp = 0u;
    for (;;) {
        sum = 0u; cnt = 0u; mine = 0u;
#pragma unroll
        for (unsigned j = 0; j < 16; ++j) { const unsigned c = xb_ld(&bar[XB_XCNT(j)]); sum += c; cnt += (c > 0u) ? 1u : 0u; mine = (j == x) ? c : mine; }
        if (sum == G) break;
        __builtin_amdgcn_s_sleep(1);
        if ((++sp & 255u) == 0u) { if (xb_ld(&bar[XB_TMO])) break; if (sp > XB_SPIN_CAP) { atomicAdd(&bar[XB_TMO], 1u); break; } }
    }
    nloc = mine > 0u ? mine : 1u; nx = cnt > 0u ? cnt : 1u;
}

__device__ __forceinline__ void xcd_barrier(const XcdBarrier& b) {
    asm volatile("s_waitcnt vmcnt(0)" ::: "memory");
    __syncthreads();
    if (threadIdx.x == 0) {
        unsigned* bar = b.bar;
        __builtin_amdgcn_s_waitcnt(0);
        unsigned nloc = b.st[0], nx = b.st[1];
        if (nloc == 0u) { xcd_barrier_complete(bar, b.x, nloc, nx); b.st[0] = nloc; b.st[1] = nx; }
        const unsigned old = xb_add(&bar[XB_XSUB(b.x)], 1u);
        const unsigned gen = old / nloc;
        if (old + 1u == (gen + 1u) * nloc) {
            __builtin_amdgcn_fence(__ATOMIC_RELEASE, "agent");
            asm volatile("s_waitcnt vmcnt(0)" ::: "memory");
            const unsigned og = xb_add(&bar[XB_TOP], 1u);
            const unsigned tg = og / nx;
            if (og + 1u == (tg + 1u) * nx) xb_add(&bar[XB_TOPGEN], 1u);
            else XB_SPIN(xb_ld(&bar[XB_TOPGEN]) == tg, bar);
            __builtin_amdgcn_fence(__ATOMIC_ACQUIRE, "agent");
            xb_add(&bar[XB_XGEN(b.x)], 1u);
            asm volatile("s_waitcnt vmcnt(0)" ::: "memory");
        } else {
            XB_SPIN(xb_ld(&bar[XB_XGEN(b.x)]) == gen, bar);
            __builtin_amdgcn_fence(__ATOMIC_ACQUIRE, "agent");
            asm volatile("s_waitcnt vmcnt(0)" ::: "memory");
        }
    }
    __syncthreads();
}


#ifndef PROBE_P3
#define PROBE_P3 1
#endif
#ifndef PROBE_P89
#define PROBE_P89 1
#endif
#ifndef PROBE_ROWS
#define PROBE_ROWS 1
#endif
struct Args { const float* in[22]; float* out; unsigned char* ws; int ph_lo, ph_hi; };
constexpr int N_PHASES = 14;

__global__ void __launch_bounds__(NTHREADS, 2) hybrid_fwd(Args args) {
    extern __shared__ __attribute__((aligned(16))) unsigned char lds_raw[];
    LAS unsigned char* lds = (LAS unsigned char*)lds_raw;
    cg::grid_group grid = cg::this_grid();
    Frame F;
    F.x = args.in[0]; F.c = args.in[1]; F.ctx = args.in[2]; F.c_ctx = args.in[3]; F.w_ada = args.in[4]; F.b_ada = args.in[5]; F.w_in = args.in[6]; F.b_in = args.in[7];
    F.mh_g = args.in[8]; F.conv_w = args.in[9]; F.conv_b = args.in[10]; F.conv_g = args.in[11]; F.conv_bb = args.in[12]; F.w_m = args.in[13]; F.w_c = args.in[14]; F.w_o = args.in[15];
    F.f1w13 = args.in[16]; F.f1w2 = args.in[17]; F.f2w13 = args.in[18]; F.f2w2 = args.in[19]; F.pg = args.in[20]; F.pb = args.in[21];
    F.out = args.out; unsigned char* ws = args.ws; F.ws = ws;
    F.mod = (float*)(ws + WS_MOD); F.bperm = (float*)(ws + WS_BPERM); F.OBUF = (float*)(ws + WS_OBUF); F.GATES = (float*)(ws + WS_GATES);
    F.W13A = (bf16_t*)(ws + WS_W13A); F.W2A = (bf16_t*)(ws + WS_W2A); F.WIN = (bf16_t*)(ws + WS_WIN); F.WM = (bf16_t*)(ws + WS_WM); F.WC = (bf16_t*)(ws + WS_AC);     F.WO = (bf16_t*)(ws + WS_WO);
    F.W13B = (bf16_t*)(ws + WS_W13B); F.W2B = (bf16_t*)(ws + WS_W2B); F.ACTA = (bf16_t*)(ws + WS_ACTA); F.HBUF = (bf16_t*)(ws + WS_HBUF);
    F.KB = (bf16_t*)(ws + WS_KB); F.VB = (bf16_t*)(ws + WS_VB); F.QB = (bf16_t*)(ws + WS_QB); F.OB = (bf16_t*)(ws + WS_OB); F.UB = (bf16_t*)(ws + WS_UB);
    F.GM = (bf16_t*)(ws + WS_GM); F.GC = (bf16_t*)(ws + WS_GC); F.AC = (bf16_t*)(ws + WS_ACTA);
    float* PART = (float*)(ws + WS_OBUF) + (size_t)MX * D; float* HF0 = (float*)(ws + WS_HBUF); float* HF1 = (float*)(ws + WS_OBUF); bf16_t* AM = (bf16_t*)(ws + WS_KB); bf16_t* MB = (bf16_t*)(ws + WS_QB);
    const int lo = args.ph_lo, hi = args.ph_hi, G = gridDim.x, bx = blockIdx.x;
#define IN(k) (lo <= (k) && (k) < hi)
#ifndef PROBE_SYNC
#define PROBE_SYNC 1
#endif
    XcdBarrier xbar; xbar.bar = (unsigned*)(ws + WS_BAR); xbar.x = 0; xbar.st = (volatile LAS unsigned*)(lds + LDS_BYTES - 64);
    if (threadIdx.x < 2) xbar.st[threadIdx.x] = 0u;
    __syncthreads();
    xbar = xcd_barrier_post((unsigned*)(ws + WS_BAR), (volatile LAS unsigned*)(lds + LDS_BYTES - 64));
#define SEAM(k) do { if (IN(k) && IN((k) + 1)) { for (int _s = 0; _s < PROBE_SYNC; ++_s) { if ((k) == 0 && lo < 0) grid.sync(); else xcd_barrier(xbar); } } } while (0)

#ifndef PROBE_P0
#define PROBE_P0 1
#endif
    if (IN(0)) { for (int rep = 0; rep < PROBE_P0; ++rep) p0_prep(F, lds); } SEAM(0);
    if (IN(1)) { for (int rep = 0; rep < PROBE_ROWS; ++rep) p_modin0(F); } SEAM(1);
    if (IN(2)) {
        pg8::Gemm g{F.ACTA, F.W13A, MT, 2 * DFF, D, D}; pg8::StaticOrder S; S.init(MT, 2 * DFF, G, bx); EpiSwiGLU E{F.HBUF};
#ifndef PROBE_P2
#define PROBE_P2 1
#endif
        for (int rep = 0; rep < PROBE_P2; ++rep) pg8::gemm_phase<EpiSwiGLU, pg8::StaticOrder, true, true>(lds, g, S, E); } SEAM(2);
    if (IN(3)) {
        pg8::Gemm g{F.HBUF, F.W2A, MT, D, DFF, DFF}; FfnDownOrder S; S.init(G, bx); EpiF32 E{F.OBUF};
        pg8::gemm_phase<EpiF32, FfnDownOrder, true, true>(lds, g, S, E); } SEAM(3);
#ifndef PROBE_P4
#define PROBE_P4 1
#endif
    if (IN(4)) { for (int rep = 0; rep < PROBE_P4; ++rep) p_residual<0>(F, 0.5f, MT, PART); } SEAM(4);
    if (IN(5)) {
        pg8::Gemm g{F.ACTA, F.WIN, MT, NINP, D, D}; InProjOrder S; S.init(G, bx);
        EpiInProj E{F.bperm, F.KB, F.VB, F.QB, F.OB, F.UB, F.GM, F.GC, F.GATES};
#ifndef PROBE_P5
#define PROBE_P5 1
#endif
        pg8::gemm_phase<EpiInProj, InProjOrder, true, true>(lds, g, S, E); } SEAM(5);
    if (IN(6)) {
#ifndef PROBE_MLSTM
#define PROBE_MLSTM 1
#endif
#ifndef PROBE_CONV
#define PROBE_CONV 1
#endif
        for (int rep = 0; rep < PROBE_MLSTM; ++rep) for (int u = bx; u < 256; u += G) mlstm_unit(F, (u & 31) * 8 + (u >> 5), lds, HF0, HF1);
        for (int rep = 0; rep < PROBE_CONV; ++rep) for (int u = bx; u < 256; u += G) conv_unit(F, u, lds);
    } SEAM(6);
    if (IN(7)) { for (int rep = 0; rep < PROBE_ROWS; ++rep) p_headnorm(F, HF0, HF1, AM); } SEAM(7);
    if (IN(8)) {
        pg8::Gemm g{F.AC, F.WC, MX, D, DCONV, D, AM, F.WM}; MergeOrder S; S.init(G, bx); EpiMerge2 E{F.GC, F.GM, MB};
        pg8::gemm_phase<EpiMerge2, MergeOrder, true, true>(lds, g, S, E); } SEAM(8);
    if (IN(9)) {
        pg8::Gemm g{MB, F.WO, MX, D, D, D}; pg8::StaticOrder S; S.init(MX, D, G, bx); EpiF32 E{F.OBUF};
        pg8::gemm_phase<EpiF32, pg8::StaticOrder, true, true>(lds, g, S, E); } SEAM(9);
    if (IN(10)) { p_residual<1>(F, 1.0f, MX, PART); } SEAM(10);
    if (IN(11)) {
        pg8::Gemm g{F.ACTA, F.W13B, MX, 2 * DFF, D, D}; pg8::StaticOrder S; S.init(MX, 2 * DFF, G, bx); EpiSwiGLU E{F.HBUF};
#ifndef PROBE_P11
#define PROBE_P11 1
#endif
        for (int rep = 0; rep < PROBE_P11; ++rep) pg8::gemm_phase<EpiSwiGLU, pg8::StaticOrder, true, true>(lds, g, S, E); } SEAM(11);
    if (IN(12)) {
        pg8::Gemm g{F.HBUF, F.W2B, MX, D, DFF, DFF}; pg8::StaticOrder S; S.init(MX, D, G, bx); EpiF32 E{F.OBUF};
#ifndef PROBE_P12
#define PROBE_P12 1
#endif
        for (int rep = 0; rep < PROBE_P12; ++rep) pg8::gemm_phase<EpiF32, pg8::StaticOrder, true, true>(lds, g, S, E); } SEAM(12);
    if (IN(13)) { p_residual<2>(F, 0.5f, MX, PART); }
#ifdef PROBE_EXTRA
    if (IN(20)) { pg8::Gemm g{F.ACTA, F.W13B, MX, 2 * DFF, D, D}; pg8::StaticOrder S; S.init(MX, 2 * DFF, G, bx); EpiNull E{F.OBUF};
        pg8::gemm_phase<EpiNull, pg8::StaticOrder, true, true>(lds, g, S, E); }
    if (IN(21)) { pg8::Gemm g{F.ACTA, F.W13B, MX, 2 * DFF, D / 2, D}; pg8::StaticOrder S; S.init(MX, 2 * DFF, G, bx); EpiNull E{F.OBUF};
        pg8::gemm_phase<EpiNull, pg8::StaticOrder, true, true>(lds, g, S, E); }
#endif
#undef IN
#undef SEAM
}

#ifndef MK_ONE_LAUNCH
#define MK_ONE_LAUNCH 1
#endif
extern "C" void kernel_launch(void* const* d_in, const int* in_sizes, int n_in, void* d_out, int out_size, void* d_ws, size_t ws_size, hipStream_t stream) {
    static int grid = 0;
    if (grid == 0) {
        if (n_in != 22 || out_size != MX * D || ws_size < WS_END) { fprintf(stderr, "kernel_launch: unexpected shapes (n_in %d out %d ws %zu, need %zu)\n", n_in, out_size, ws_size, (size_t)WS_END); grid = -1; return; }
        int dev = 0, cus = 0, per_cu = 0;
        (void)hipGetDevice(&dev); (void)hipDeviceGetAttribute(&cus, hipDeviceAttributeMultiprocessorCount, dev);
        if (hipFuncSetAttribute((const void*)hybrid_fwd, hipFuncAttributeMaxDynamicSharedMemorySize, LDS_BYTES) != hipSuccess) { fprintf(stderr, "kernel_launch: hipFuncSetAttribute failed\n"); grid = -1; return; }
        if (hipOccupancyMaxActiveBlocksPerMultiprocessor(&per_cu, (const void*)hybrid_fwd, NTHREADS, LDS_BYTES) != hipSuccess || per_cu < 1) { fprintf(stderr, "kernel_launch: occupancy query says %d\n", per_cu); (void)hipGetLastError(); per_cu = 1; }
        grid = cus * per_cu; if (grid > 256) grid = 256;
    }
    if (grid < 0) return;
    Args a{};
    for (int i = 0; i < 22; ++i) a.in[i] = (const float*)d_in[i];
    a.out = (float*)d_out; a.ws = (unsigned char*)d_ws;
    if (hipMemsetAsync((char*)d_ws + WS_BAR, 0, XCD_BAR_WORDS * 4, stream) != hipSuccess) { fprintf(stderr, "kernel_launch: memset of the barrier words failed\n"); return; }
#if MK_ONE_LAUNCH
    a.ph_lo = 0; a.ph_hi = N_PHASES;
    void* kargs[] = {&a};
    const hipError_t e = hipLaunchCooperativeKernel((const void*)hybrid_fwd, dim3(grid), dim3(NTHREADS), kargs, (size_t)LDS_BYTES, stream);
    if (e != hipSuccess) fprintf(stderr, "kernel_launch: cooperative launch failed: %s (grid %d)\n", hipGetErrorString(e), grid);
#ifdef PROBE_EXTRA
    { const int ph[] = {PROBE_EXTRA}; for (int p : ph) { a.ph_lo = p; a.ph_hi = p + 1; hipLaunchKernelGGL(hybrid_fwd, dim3(grid), dim3(NTHREADS), LDS_BYTES, stream, a); } }
#endif
#else
    for (int p = 0; p < N_PHASES; ++p) { a.ph_lo = p; a.ph_hi = p + 1; hipLaunchKernelGGL(hybrid_fwd, dim3(grid), dim3(NTHREADS), LDS_BYTES, stream, a); }
#endif
}
```
